# Optimizing an MI355X kernel written in HIP

```python
import jax, jax.numpy as jnp
from jax import lax
import numpy as np

D_MODEL = 2048
BATCH = 8
SEQ = 2048
DEPTH = 2

MIX_WIDTH = D_MODEL
N_GROUPS = 4
GROUP_WIDTH = MIX_WIDTH // N_GROUPS
POOL_WINDOWS = (2, 4, 8, 16)
POOL_GROUP = GROUP_WIDTH // len(POOL_WINDOWS)
SGU_HEADS = 4
SGU_HEAD_DIM = GROUP_WIDTH // SGU_HEADS
SGU_CHUNK = 128
FOX_HEADS = 4
FOX_HEAD_DIM = GROUP_WIDTH // FOX_HEADS
FOX_BLOCK = 128
RET_HEADS = 4
RET_V_DIM = GROUP_WIDTH // RET_HEADS
RET_QK_DIM = RET_V_DIM // 2
RET_CHUNK = 128
ROPE_BASE = 10000.0
D_FF = 4 * D_MODEL
EPS = 1e-6
NEG_BIG = -1e30
SPLIT_SIZES = (GROUP_WIDTH,
               GROUP_WIDTH, GROUP_WIDTH,
               GROUP_WIDTH, GROUP_WIDTH, GROUP_WIDTH, FOX_HEADS,
               RET_HEADS * RET_QK_DIM, RET_HEADS * RET_QK_DIM, GROUP_WIDTH, GROUP_WIDTH)
IN_COLS = 9 * GROUP_WIDTH + FOX_HEADS + 2 * RET_HEADS * RET_QK_DIM

kernel_name = 'hymba_style_pool_sgu_fox_retention_hybrid'


def split_columns(proj):
    pieces, start = [], 0
    for size in SPLIT_SIZES:
        pieces.append(proj[..., start:start + size])
        start += size
    return pieces


def rmsnorm(x, g):
    xf = x.astype(jnp.float32)
    y = xf * lax.rsqrt(jnp.mean(xf * xf, axis=-1, keepdims=True) + EPS)
    return (y * g.astype(jnp.float32)).astype(x.dtype)


def head_layernorm(x, g, n_heads, head_dim):
    B, S, _ = x.shape
    xf = x.astype(jnp.float32).reshape(B, S, n_heads, head_dim)
    mu = jnp.mean(xf, axis=-1, keepdims=True)
    var = jnp.mean(jnp.square(xf - mu), axis=-1, keepdims=True)
    y = (xf - mu) * lax.rsqrt(var + EPS) * g.astype(jnp.float32).reshape(n_heads, head_dim)
    return y.reshape(B, S, n_heads * head_dim).astype(x.dtype)


def pool_mixer(a, pool_w, pool_scale):
    B, S, _ = a.shape
    af = a.astype(jnp.float32)
    cs = jnp.cumsum(af, axis=1)
    outs = []
    for gi, w in enumerate(POOL_WINDOWS):
        lo, hi = gi * POOL_GROUP, (gi + 1) * POOL_GROUP
        c = cs[..., lo:hi]
        c_prev = jnp.pad(c[:, :S - w], ((0, 0), (w, 0), (0, 0)))
        cnt = jnp.minimum(jnp.arange(1, S + 1, dtype=jnp.float32), float(w))[None, :, None]
        outs.append((c - c_prev) / cnt - af[..., lo:hi])
    p = jnp.stack(outs, axis=2).astype(a.dtype)
    y = jnp.einsum('bsgc,gcd->bsgd', p, pool_w).reshape(B, S, GROUP_WIDTH)
    return y * pool_scale


def sgu_mixer(u, v, norm_g, w_s, b_s):
    B, S, _ = u.shape
    u = jax.nn.gelu(u)
    v = head_layernorm(jax.nn.gelu(v), norm_g, SGU_HEADS, SGU_HEAD_DIM)
    vc = v.reshape(B, S // SGU_CHUNK, SGU_CHUNK, SGU_HEADS, SGU_HEAD_DIM)
    mask = jnp.tril(jnp.ones((SGU_CHUNK, SGU_CHUNK), dtype=jnp.float32)).astype(w_s.dtype)
    z = jnp.einsum('hts,bcshd->bcthd', w_s * mask[None], vc)
    z = z + jnp.transpose(b_s)[None, None, :, :, None]
    return u * z.reshape(B, S, GROUP_WIDTH)


def fox_mixer(q, k, v, f_logit, b_f):
    B, S, _ = q.shape
    q = q.reshape(B, S, FOX_HEADS, FOX_HEAD_DIM).transpose(0, 2, 1, 3)
    k = k.reshape(B, S, FOX_HEADS, FOX_HEAD_DIM).transpose(0, 2, 1, 3)
    v = v.reshape(B, S, FOX_HEADS, FOX_HEAD_DIM).transpose(0, 2, 1, 3)
    log_f = jax.nn.log_sigmoid(f_logit.astype(jnp.float32) + b_f.astype(jnp.float32))
    c = jnp.cumsum(log_f, axis=1).transpose(0, 2, 1)
    scale = FOX_HEAD_DIM ** -0.5
    outs = []
    for i in range(S // FOX_BLOCK):
        start, end = i * FOX_BLOCK, (i + 1) * FOX_BLOCK
        qb = q[:, :, start:end]
        kb = k[:, :, :end]
        vb = v[:, :, :end]
        cq = c[:, :, start:end]
        ck = c[:, :, :end]
        s = jnp.einsum('bhqd,bhkd->bhqk', qb, kb).astype(jnp.float32) * scale
        s = s + (cq[..., :, None] - ck[..., None, :])
        qpos = start + jnp.arange(FOX_BLOCK)
        kpos = jnp.arange(end)
        s = jnp.where(kpos[None, :] <= qpos[:, None], s, NEG_BIG)
        p = jax.nn.softmax(s, axis=-1)
        outs.append(jnp.einsum('bhqk,bhkd->bhqd', p.astype(vb.dtype), vb))
    o = jnp.concatenate(outs, axis=2)
    return o.transpose(0, 2, 1, 3).reshape(B, S, GROUP_WIDTH)


def rotary(x, pos):
    half = x.shape[-1] // 2
    inv = jnp.exp(-(jnp.arange(half, dtype=jnp.float32) / half) * np.float32(np.log(ROPE_BASE)))
    ang = pos[:, None] * inv[None, :]
    cos = jnp.cos(ang)[None, :, None, :]
    sin = jnp.sin(ang)[None, :, None, :]
    x1, x2 = x[..., :half], x[..., half:]
    return jnp.concatenate([x1 * cos - x2 * sin, x1 * sin + x2 * cos], axis=-1)


def retention_mixer(q, k, v, g, norm_g):
    B, S, _ = q.shape
    L = RET_CHUNK
    nC = S // L
    pos = jnp.arange(S, dtype=jnp.float32)
    qf = rotary(q.astype(jnp.float32).reshape(B, S, RET_HEADS, RET_QK_DIM), pos)
    kf = rotary(k.astype(jnp.float32).reshape(B, S, RET_HEADS, RET_QK_DIM), pos) * (RET_QK_DIM ** -0.5)
    vf = v.astype(jnp.float32).reshape(B, S, RET_HEADS, RET_V_DIM)
    gamma = 1.0 - jnp.exp((-5.0 - jnp.arange(RET_HEADS, dtype=jnp.float32)) * np.float32(np.log(2.0)))
    log_gamma = jnp.log(gamma)
    l = jnp.arange(L, dtype=jnp.float32)
    diff = l[:, None] - l[None, :]
    decay = jnp.where(diff[None] >= 0, jnp.exp(jnp.maximum(diff, 0.0)[None] * log_gamma[:, None, None]), 0.0)
    qc = qf.reshape(B, nC, L, RET_HEADS, RET_QK_DIM)
    kc = kf.reshape(B, nC, L, RET_HEADS, RET_QK_DIM)
    vc = vf.reshape(B, nC, L, RET_HEADS, RET_V_DIM)
    s = jnp.einsum('bclhd,bcmhd->bchlm', qc, kc) * decay[None, None]
    y_intra = jnp.einsum('bchlm,bcmhe->bclhe', s, vc)
    xi = jnp.exp((l + 1.0)[:, None] * log_gamma[None, :])
    zeta = jnp.exp((L - 1.0 - l)[:, None] * log_gamma[None, :])
    chunk_decay = jnp.exp(L * log_gamma)

    def step(R, inp):
        qi, ki, vi = inp
        y = jnp.einsum('blhd,bhde->blhe', qi, R) * xi[None, :, :, None]
        R = R * chunk_decay[None, :, None, None] + jnp.einsum('blhd,blhe->bhde', ki * zeta[None, :, :, None], vi)
        return R, y

    R0 = jnp.zeros((B, RET_HEADS, RET_QK_DIM, RET_V_DIM), jnp.float32)
    xs = (jnp.moveaxis(qc, 1, 0), jnp.moveaxis(kc, 1, 0), jnp.moveaxis(vc, 1, 0))
    _, y_cross = lax.scan(step, R0, xs)
    y = (y_intra + jnp.moveaxis(y_cross, 0, 1)).reshape(B, S, GROUP_WIDTH)
    y = head_layernorm(y, norm_g, RET_HEADS, RET_V_DIM).astype(g.dtype)
    return jax.nn.silu(g) * y


def setup_inputs(seed: int = 0) -> dict:
    key = jax.random.key(seed)
    ks = jax.random.split(key, 16)
    f32 = jnp.float32

    def nrm(k, shape, s):
        return jax.random.normal(k, shape, f32) * s

    return {
        'x': jax.random.normal(ks[0], (BATCH, SEQ, D_MODEL), f32),
        'norm_mix_g': 1.0 + nrm(ks[1], (DEPTH, D_MODEL), 0.05),
        'w_in': nrm(ks[2], (DEPTH, D_MODEL, IN_COLS), D_MODEL ** -0.5),
        'fox_b_f': 2.0 + nrm(ks[3], (DEPTH, FOX_HEADS), 0.5),
        'pool_w': nrm(ks[4], (DEPTH, len(POOL_WINDOWS), POOL_GROUP, POOL_GROUP), POOL_GROUP ** -0.5),
        'pool_scale': 1.0 + nrm(ks[5], (DEPTH, GROUP_WIDTH), 0.1),
        'sgu_norm_g': 1.0 + nrm(ks[6], (DEPTH, GROUP_WIDTH), 0.05),
        'sgu_w_s': nrm(ks[7], (DEPTH, SGU_HEADS, SGU_CHUNK, SGU_CHUNK), SGU_CHUNK ** -0.5),
        'sgu_b': 1.0 + nrm(ks[8], (DEPTH, SGU_HEADS, SGU_CHUNK), 0.1),
        'ret_norm_g': 1.0 + nrm(ks[9], (DEPTH, GROUP_WIDTH), 0.05),
        'w_out': nrm(ks[10], (DEPTH, MIX_WIDTH, D_MODEL), MIX_WIDTH ** -0.5),
        'norm_mlp_g': 1.0 + nrm(ks[11], (DEPTH, D_MODEL), 0.05),
        'w_ff1': nrm(ks[12], (DEPTH, D_MODEL, D_FF), D_MODEL ** -0.5),
        'w_ff2': nrm(ks[13], (DEPTH, D_FF, D_MODEL), D_FF ** -0.5),
        'norm_final_g': 1.0 + nrm(ks[14], (D_MODEL,), 0.05),
    }


def reference(x, norm_mix_g, w_in, fox_b_f, pool_w, pool_scale, sgu_norm_g, sgu_w_s, sgu_b,
              ret_norm_g, w_out, norm_mlp_g, w_ff1, w_ff2, norm_final_g):
    h = x
    for layer in range(DEPTH):
        xn = rmsnorm(h, norm_mix_g[layer])
        proj = jnp.einsum('bsd,dc->bsc', xn, w_in[layer])
        (a_in, u_in, v_in, q_f, k_f, v_f, f_logit,
         q_r, k_r, v_r, g_r) = split_columns(proj)
        y_a = pool_mixer(a_in, pool_w[layer], pool_scale[layer])
        y_b = sgu_mixer(u_in, v_in, sgu_norm_g[layer], sgu_w_s[layer], sgu_b[layer])
        y_c = fox_mixer(q_f, k_f, v_f, f_logit, fox_b_f[layer])
        y_d = retention_mixer(q_r, k_r, v_r, g_r, ret_norm_g[layer])
        mix = jnp.concatenate([y_a, y_b, y_c, y_d], axis=-1)
        h = h + jnp.einsum('bsc,cd->bsd', mix, w_out[layer])
        hn = rmsnorm(h, norm_mlp_g[layer])
        ff = jnp.square(jax.nn.relu(jnp.einsum('bsd,df->bsf', hn, w_ff1[layer])))
        h = h + jnp.einsum('bsf,fd->bsd', ff, w_ff2[layer])
    return rmsnorm(h, norm_final_g)
```

```cpp
#include <hip/hip_runtime.h>
#include <hip/hip_cooperative_groups.h>
#include <cstdio>
#include <cstdint>
namespace cg = cooperative_groups;
namespace pg8 {
#define PG8_LAS __attribute__((address_space(3)))
typedef unsigned short bf16_t;
typedef short bf16x8 __attribute__((ext_vector_type(8)));
typedef float f32x4 __attribute__((ext_vector_type(4)));
typedef unsigned u32x4 __attribute__((ext_vector_type(4)));
constexpr int BM = 256, BK = 64, HALF = 128, HTB = HALF * BK * 2  , STAGE_BYTES = 8 * HTB, NXCD = 8, WGM = 8;

__host__ __device__ __forceinline__ int lds_byte(int r, int c) { const int st = (r >> 4) * 2 + (c >> 5), rr = r & 15, cc = c & 31, ob = rr * 64 + cc * 2; return st * 1024 + (ob ^ (((ob >> 9) & 1) << 5)); }
__host__ __device__ __forceinline__ void stage_rc(int b, int& R, int& C) { const int st = b / 1024, sb = b % 1024, swz = sb ^ (((sb >> 9) & 1) << 5); R = (st >> 1) * 16 + swz / 64; C = (st & 1) * 32 + (swz % 64) / 2; }
__host__ __device__ __forceinline__ int perm32(int rho) { const int n = rho >> 4, i = rho & 15; return 8 * (i >> 2) + 4 * n + (i & 3); }

struct Unit { int pm, pn; };
struct Gemm { const bf16_t* A; const bf16_t* Bt; int M, N, K; };

struct StaticOrder {
    int nM, nN, nwg, G, c, wgm;
    __host__ __device__ void init(int M, int N, int G_, int c_, int wgm_ = WGM) { nM = M / BM; nN = N / BM; nwg = nM * nN; G = G_; c = c_; wgm = wgm_; }
    __host__ __device__ bool next(int i, Unit& u) const {
        const long L = (long)i * G + c; if (L >= nwg) return false;
        int wgid = (int)L; { const int q = nwg / NXCD, r = nwg % NXCD, xcd = wgid % NXCD, off = wgid / NXCD; wgid = (xcd < r ? xcd * (q + 1) : r * (q + 1) + (xcd - r) * q) + off; }
        const int nig = wgm * nN, gid = wgid / nig, fm = gid * wgm, gsz = (nM - fm) < wgm ? (nM - fm) : wgm;
        u.pm = fm + ((wgid % nig) % gsz); u.pn = (wgid % nig) / gsz; return true;
    }
    __device__ __forceinline__ void a_ready(const Unit&, int, PG8_LAS unsigned char*) const {}
    __device__ __forceinline__ void done(const Unit&) const {}
};

typedef float f32x2c __attribute__((ext_vector_type(2)));
typedef __bf16 bf16x2c __attribute__((ext_vector_type(2)));
__device__ __forceinline__ unsigned cvt_pk_bf16(float lo, float hi) { const f32x2c v = {lo, hi}; const bf16x2c b = __builtin_convertvector(v, bf16x2c); return __builtin_bit_cast(unsigned, b); }
template <class Epi, class Sched, bool ALIGN_EPI = false, bool SP2 = false>
__device__ __forceinline__ void gemm_phase(PG8_LAS unsigned char* lds, const Gemm g, const Sched& S, const Epi& E) {
    int tid_l = threadIdx.x; asm volatile("" : "+v"(tid_l)); const int tid = tid_l, wid = __builtin_amdgcn_readfirstlane(tid >> 6), lane = tid & 63, wr = wid >> 2, wc = wid & 3, fr = lane & 15, fq = lane >> 4;
    const int K = g.K, nt = K / BK;
    unsigned voffA[2], voffB[2];
#pragma unroll
    for (int i = 0; i < 2; ++i) { int R, C; stage_rc(tid * 16 + i * 8192, R, C); const int Rb = Epi::PERM ? ((R & ~31) + perm32(R & 31)) : R;
        voffA[i] = (unsigned)(R * K + C) * 2u; voffB[i] = (unsigned)(Rb * K + C) * 2u; }
    const size_t kstep = (size_t)(BK * 2);
    const size_t hstep = (size_t)HALF * K * 2;
    const size_t tstep = 2 * hstep;
    const unsigned ldsw = (unsigned)wid * 1024u;
    const int aoff = lds_byte(wr * 64 + fr, fq * 8), boff = lds_byte(wc * 32 + fr, fq * 8);
#define PG8_SA(b, h) (((b) * 2 + (h)) * HTB)
#define PG8_SB(b, h) ((4 + (b) * 2 + (h)) * HTB)
#define PG8_STAGE(bufoff, gbase, voff) do { _Pragma("unroll") for (int _i = 0; _i < 2; ++_i) \
        __builtin_amdgcn_global_load_lds((const unsigned*)((const char*)(gbase) + (voff)[_i]), (PG8_LAS unsigned*)(lds + (bufoff) + ldsw + _i * 8192), 16, 0, 0); } while (0)
#define PG8_LDA(dst, b, h) do { _Pragma("unroll") for (int m = 0; m < 4; ++m) _Pragma("unroll") for (int k = 0; k < 2; ++k) dst[m][k] = *(const PG8_LAS bf16x8*)(lds + PG8_SA(b, h) + aoff + m * 2048 + k * 1024); } while (0)
#define PG8_LDB(dst, b, h) do { _Pragma("unroll") for (int n = 0; n < 2; ++n) _Pragma("unroll") for (int k = 0; k < 2; ++k) dst[n][k] = *(const PG8_LAS bf16x8*)(lds + PG8_SB(b, h) + boff + n * 2048 + k * 1024); } while (0)
#define PG8_MMA(ai, bj, At, Bt) do { __builtin_amdgcn_s_setprio(1); _Pragma("unroll") for (int m = 0; m < 4; ++m) _Pragma("unroll") for (int n = 0; n < 2; ++n) _Pragma("unroll") for (int k = 0; k < 2; ++k) \
        acc[ai][bj][m][n] = __builtin_amdgcn_mfma_f32_16x16x32_bf16(Bt[n][k], At[m][k], acc[ai][bj][m][n], 0, 0, 0); __builtin_amdgcn_s_setprio(0); } while (0)
#define PG8_WAIT_V(n) asm volatile("s_waitcnt vmcnt(" #n ")" ::: "memory")
#define PG8_WAIT_L(n) asm volatile("s_waitcnt lgkmcnt(" #n ")" ::: "memory")
#define PG8_BAR __builtin_amdgcn_s_barrier()
#define PG8_SCHED __builtin_amdgcn_sched_barrier(0)
    Unit cur, nxt; int ui = 0;
    if (!S.next(0, cur)) return;
    f32x4 acc[2][2][4][2];
#pragma unroll
    for (int a = 0; a < 2; ++a)
#pragma unroll
        for (int b = 0; b < 2; ++b)
#pragma unroll
            for (int m = 0; m < 4; ++m)
#pragma unroll
                for (int n = 0; n < 2; ++n) acc[a][b][m][n] = (f32x4){0.f, 0.f, 0.f, 0.f};
    bf16x8 At[4][2], B0[2][2], B1[2][2];
    const char* cA = (const char*)g.A + (size_t)cur.pm * tstep; const char* cB = (const char*)g.Bt + (size_t)cur.pn * tstep;
    S.a_ready(cur, 0, lds);
    if constexpr (SP2) {
        PG8_STAGE(PG8_SB(0, 0), cB, voffB); PG8_STAGE(PG8_SB(0, 1), cB + hstep, voffB); PG8_STAGE(PG8_SA(0, 0), cA, voffA); PG8_STAGE(PG8_SA(0, 1), cA + hstep, voffA);
        if (wr == 1) PG8_BAR;
        PG8_WAIT_V(2); PG8_BAR;
        PG8_STAGE(PG8_SB(1, 0), cB + kstep, voffB); PG8_STAGE(PG8_SA(1, 0), cA + kstep, voffA); PG8_STAGE(PG8_SB(1, 1), cB + hstep + kstep, voffB);
        PG8_WAIT_V(6); PG8_BAR;
    } else {
        PG8_STAGE(PG8_SB(0, 0), cB, voffB); PG8_STAGE(PG8_SA(0, 0), cA, voffA); PG8_STAGE(PG8_SB(0, 1), cB + hstep, voffB); PG8_STAGE(PG8_SA(0, 1), cA + hstep, voffA);
        if (wr == 1) PG8_BAR;
        PG8_WAIT_V(4); PG8_BAR;
        PG8_STAGE(PG8_SB(1, 0), cB + kstep, voffB); PG8_STAGE(PG8_SA(1, 0), cA + kstep, voffA); PG8_STAGE(PG8_SB(1, 1), cB + hstep + kstep, voffB);
        PG8_WAIT_V(6); PG8_BAR;
    }
    for (;;) {
        const bool has_next = S.next(ui + 1, nxt);
        const char* nA = has_next ? (const char*)g.A + (size_t)nxt.pm * tstep : cA; const char* nB = has_next ? (const char*)g.Bt + (size_t)nxt.pn * tstep : cB;
        for (int t = 0; t < nt; t += 2) {
            const bool last = (t == nt - 2);
            const char* a1 = cA + (size_t)(t + 1) * kstep;
            const char* a2 = last ? nA : cA + (size_t)(t + 2) * kstep; const char* b2 = last ? nB : cB + (size_t)(t + 2) * kstep;
            const char* a3 = a2 + kstep; const char* b3 = b2 + kstep;
            if (last && has_next) S.a_ready(nxt, (ui + 1) & 1, lds);
            if constexpr (SP2) {
            PG8_LDB(B0, 0, 0); PG8_LDB(B1, 0, 1); PG8_SCHED; PG8_LDA(At, 0, 0); PG8_STAGE(PG8_SA(1, 1), a1 + hstep, voffA);
            PG8_WAIT_V(8); PG8_WAIT_L(0); PG8_BAR; PG8_MMA(0, 0, At, B0); PG8_MMA(0, 1, At, B1); PG8_BAR; PG8_SCHED;
            PG8_LDA(At, 0, 1); PG8_STAGE(PG8_SB(0, 0), b2, voffB); PG8_STAGE(PG8_SB(0, 1), b2 + hstep, voffB); PG8_STAGE(PG8_SA(0, 0), a2, voffA);
            PG8_WAIT_V(8); PG8_WAIT_L(0); PG8_BAR; PG8_MMA(1, 0, At, B0); PG8_MMA(1, 1, At, B1); PG8_BAR; PG8_SCHED;
            PG8_LDB(B0, 1, 0); PG8_LDB(B1, 1, 1); PG8_SCHED; PG8_LDA(At, 1, 0); PG8_STAGE(PG8_SA(0, 1), a2 + hstep, voffA);
            PG8_WAIT_V(8); PG8_WAIT_L(0); PG8_BAR; PG8_MMA(0, 0, At, B0); PG8_MMA(0, 1, At, B1); PG8_BAR; PG8_SCHED;
            PG8_LDA(At, 1, 1); PG8_STAGE(PG8_SB(1, 0), b3, voffB); PG8_STAGE(PG8_SB(1, 1), b3 + hstep, voffB); PG8_STAGE(PG8_SA(1, 0), a3, voffA);
            PG8_WAIT_V(8); PG8_WAIT_L(0); PG8_BAR; PG8_MMA(1, 0, At, B0); PG8_MMA(1, 1, At, B1); PG8_BAR; PG8_SCHED;
            } else {
            PG8_LDB(B0, 0, 0); PG8_SCHED; PG8_LDA(At, 0, 0); PG8_STAGE(PG8_SA(1, 1), a1 + hstep, voffA);
            PG8_WAIT_L(8); PG8_BAR; PG8_WAIT_L(0); PG8_MMA(0, 0, At, B0); PG8_BAR; PG8_SCHED;
            PG8_LDB(B1, 0, 1); PG8_STAGE(PG8_SB(0, 0), b2, voffB);
            PG8_BAR; PG8_WAIT_L(0); PG8_MMA(0, 1, At, B1); PG8_BAR;
            PG8_LDA(At, 0, 1); PG8_STAGE(PG8_SA(0, 0), a2, voffA);
            PG8_BAR; PG8_WAIT_L(0); PG8_MMA(1, 0, At, B0); PG8_BAR; PG8_SCHED;
            PG8_STAGE(PG8_SB(0, 1), b2 + hstep, voffB);
            PG8_WAIT_V(6); PG8_BAR; PG8_MMA(1, 1, At, B1); PG8_BAR;
            PG8_LDB(B0, 1, 0); PG8_SCHED; PG8_LDA(At, 1, 0); PG8_STAGE(PG8_SA(0, 1), a2 + hstep, voffA);
            PG8_WAIT_L(8); PG8_BAR; PG8_WAIT_L(0); PG8_MMA(0, 0, At, B0); PG8_BAR; PG8_SCHED;
            PG8_LDB(B1, 1, 1); PG8_STAGE(PG8_SB(1, 0), b3, voffB);
            PG8_BAR; PG8_WAIT_L(0); PG8_MMA(0, 1, At, B1); PG8_BAR;
            PG8_LDA(At, 1, 1); PG8_STAGE(PG8_SA(1, 0), a3, voffA);
            PG8_BAR; PG8_WAIT_L(0); PG8_MMA(1, 0, At, B0); PG8_BAR; PG8_SCHED;
            PG8_STAGE(PG8_SB(1, 1), b3 + hstep, voffB);
            PG8_WAIT_V(6); PG8_BAR; PG8_MMA(1, 1, At, B1); PG8_BAR;
            }
        }
        if constexpr (ALIGN_EPI) { if (wr == 0) PG8_BAR; }
        if constexpr (!Epi::AFTER_DRAIN) { E(acc, cur, wr, wc, fr, fq, ui & 1, lds); S.done(cur); }
        if (!has_next) break;
#pragma unroll
        for (int a = 0; a < 2; ++a)
#pragma unroll
            for (int b = 0; b < 2; ++b)
#pragma unroll
                for (int m = 0; m < 4; ++m)
#pragma unroll
                    for (int n = 0; n < 2; ++n) acc[a][b][m][n] = (f32x4){0.f, 0.f, 0.f, 0.f};
        cur = nxt; cA = nA; cB = nB; ++ui;
        if constexpr (ALIGN_EPI) { if (wr == 1) PG8_BAR; }
    }
    PG8_WAIT_V(0);
    if constexpr (!ALIGN_EPI) { if (wr == 0) PG8_BAR; }
    PG8_BAR;
    if constexpr (Epi::AFTER_DRAIN) { E.fused(acc, cur, wr, wc, fr, fq, lds, wid, lane); S.done(cur); }
#undef PG8_SA
#undef PG8_SB
#undef PG8_STAGE
#undef PG8_LDA
#undef PG8_LDB
#undef PG8_MMA
#undef PG8_WAIT_V
#undef PG8_WAIT_L
#undef PG8_BAR
#undef PG8_SCHED
}
}
namespace pg8 {
constexpr int RS_LDS_OFF = 145152;
struct RsOrder : StaticOrder {
    const float* rs;
    __device__ __forceinline__ void a_ready(const Unit& u, int slot, PG8_LAS unsigned char* lds) const {
        const int t = threadIdx.x, w = __builtin_amdgcn_readfirstlane(t >> 6);
        const float* base = rs + (u.pm * BM + w * 64);
        if (w < 4) __builtin_amdgcn_global_load_lds((const unsigned*)base + (t & 63), (PG8_LAS unsigned*)(lds + RS_LDS_OFF + slot * 1024 + w * 256), 4, 0, 0);
    }
};
struct EpiProj {
    static constexpr bool PERM = true, AFTER_DRAIN = false;
    bf16_t* O; const float* rot; const float* bf; float* logf;
    __device__ __forceinline__ void operator()(const f32x4 (&acc)[2][2][4][2], const Unit& u, int wr, int wc, int fr, int fq, int slot, PG8_LAS unsigned char* lds) const {
        const int row0 = u.pm * BM + wr * 64 + fr, col0 = u.pn * BM + wc * 32 + 8 * fq;
        const PG8_LAS float* rsl = (const PG8_LAS float*)(lds + RS_LDS_OFF + slot * 1024) + wr * 64 + fr;
        const bool rotary = (u.pn == 12) || (u.pn == 13); const float ksc = (u.pn == 13) ? 0.125f : 1.0f;
        if (u.pn == 18) {
            if (wc == 0 && fq == 0) { const f32x4 bv = *(const f32x4*)bf;
#pragma unroll
                for (int ai = 0; ai < 2; ++ai)
#pragma unroll
                    for (int m = 0; m < 4; ++m) { const int row = row0 + ai * HALF + m * 16; const f32x4 x = acc[ai][0][m][0] * rsl[ai * HALF + m * 16] + bv; f32x4 o;
#pragma unroll
                        for (int j = 0; j < 4; ++j) o[j] = fminf(x[j], 0.f) - log1pf(expf(-fabsf(x[j])));
                        *(f32x4*)(logf + (size_t)row * 4) = o; } }
            return; }
#pragma unroll
        for (int ai = 0; ai < 2; ++ai)
#pragma unroll
            for (int m = 0; m < 4; ++m) { const int row = row0 + ai * HALF + m * 16; bf16_t* rowp = O + (size_t)row * 4608 + col0; const float rsv = rsl[ai * HALF + m * 16];
#pragma unroll
                for (int bj = 0; bj < 2; ++bj) { f32x4 v0 = acc[ai][bj][m][0] * rsv, v1 = acc[ai][bj][m][1] * rsv;
                    if (rotary) { const int pos = row & 2047, i0 = ((bj * HALF + wc * 32 + 8 * fq) & 63) >> 1;
                        const f32x4 r0 = *(const f32x4*)(rot + (size_t)(pos * 32 + i0) * 2), r1 = *(const f32x4*)(rot + (size_t)(pos * 32 + i0) * 2 + 4);
                        f32x4 a, b;
                        a[0] = (v0[0] * r0[0] - v0[1] * r0[1]) * ksc; a[1] = (v0[0] * r0[1] + v0[1] * r0[0]) * ksc;
                        a[2] = (v0[2] * r0[2] - v0[3] * r0[3]) * ksc; a[3] = (v0[2] * r0[3] + v0[3] * r0[2]) * ksc;
                        b[0] = (v1[0] * r1[0] - v1[1] * r1[1]) * ksc; b[1] = (v1[0] * r1[1] + v1[1] * r1[0]) * ksc;
                        b[2] = (v1[2] * r1[2] - v1[3] * r1[3]) * ksc; b[3] = (v1[2] * r1[3] + v1[3] * r1[2]) * ksc;
                        v0 = a; v1 = b; }
                    u32x4 w; w.x = cvt_pk_bf16(v0[0], v0[1]); w.y = cvt_pk_bf16(v0[2], v0[3]); w.z = cvt_pk_bf16(v1[0], v1[1]); w.w = cvt_pk_bf16(v1[2], v1[3]);
                    *(u32x4*)(rowp + bj * HALF) = w; } }
    }
};
struct EpiRelu2 {
    static constexpr bool PERM = true, AFTER_DRAIN = false;
    bf16_t* O; int ldc;
    __device__ __forceinline__ void operator()(const f32x4 (&acc)[2][2][4][2], const Unit& u, int wr, int wc, int fr, int fq, int slot, PG8_LAS unsigned char* lds) const {
        const int row0 = u.pm * BM + wr * 64 + fr, col0 = u.pn * BM + wc * 32 + 8 * fq;
#pragma unroll
        for (int ai = 0; ai < 2; ++ai)
#pragma unroll
            for (int m = 0; m < 4; ++m) { bf16_t* rowp = O + (size_t)(row0 + ai * HALF + m * 16) * ldc + col0; const float rsv = ((const PG8_LAS float*)(lds + RS_LDS_OFF + slot * 1024))[wr * 64 + fr + ai * HALF + m * 16];
#pragma unroll
                for (int bj = 0; bj < 2; ++bj) { f32x4 v0 = acc[ai][bj][m][0] * rsv, v1 = acc[ai][bj][m][1] * rsv;
#pragma unroll
                    for (int j = 0; j < 4; ++j) { const float a = fmaxf(v0[j], 0.f), b = fmaxf(v1[j], 0.f); v0[j] = a * a; v1[j] = b * b; }
                    u32x4 w; w.x = cvt_pk_bf16(v0[0], v0[1]); w.y = cvt_pk_bf16(v0[2], v0[3]); w.z = cvt_pk_bf16(v1[0], v1[1]); w.w = cvt_pk_bf16(v1[2], v1[3]);
                    *(u32x4*)(rowp + bj * HALF) = w; } }
    }
};
template <bool COPY> struct EpiResid {
    static constexpr bool PERM = true, AFTER_DRAIN = false;
    const float* res; float* out; bf16_t* xn; float* ssp; int ldc;
    __device__ __forceinline__ void operator()(const f32x4 (&acc)[2][2][4][2], const Unit& u, int wr, int wc, int fr, int fq, int slot, PG8_LAS unsigned char* lds) const {
        const int row0 = u.pm * BM + wr * 64 + fr, col0 = u.pn * BM + wc * 32 + 8 * fq;
#pragma unroll
        for (int ai = 0; ai < 2; ++ai)
#pragma unroll
            for (int m = 0; m < 4; ++m) { const int row = row0 + ai * HALF + m * 16; const size_t off = (size_t)row * ldc + col0; float ss = 0.f;
#pragma unroll
                for (int bj = 0; bj < 2; ++bj) {
                    const f32x4 h0 = *(const f32x4*)(res + off + bj * HALF) + acc[ai][bj][m][0], h1 = *(const f32x4*)(res + off + bj * HALF + 4) + acc[ai][bj][m][1];
                    *(f32x4*)(out + off + bj * HALF) = h0; *(f32x4*)(out + off + bj * HALF + 4) = h1;
                    if (COPY) { u32x4 w; w.x = cvt_pk_bf16(h0[0], h0[1]); w.y = cvt_pk_bf16(h0[2], h0[3]); w.z = cvt_pk_bf16(h1[0], h1[1]); w.w = cvt_pk_bf16(h1[2], h1[3]);
                        *(u32x4*)(xn + off + bj * HALF) = w;
                        ss += (h0[0] * h0[0] + h0[1] * h0[1]) + (h0[2] * h0[2] + h0[3] * h0[3]) + (h1[0] * h1[0] + h1[1] * h1[1]) + (h1[2] * h1[2] + h1[3] * h1[3]); } }
                if (COPY) { ss += __shfl_xor(ss, 16); ss += __shfl_xor(ss, 32);
                    if (fq == 0) ssp[(size_t)row * 32 + u.pn * 4 + wc] = ss; }
                if (m == 3) asm volatile("" ::: "memory"); }
    }
};
}
#define DEV __device__ __forceinline__
#ifndef LAS
#define LAS __attribute__((address_space(3)))
#endif
typedef unsigned short bf16_t;
typedef short bf16x8 __attribute__((ext_vector_type(8)));
typedef short s16x4 __attribute__((ext_vector_type(4)));
typedef float f32x4 __attribute__((ext_vector_type(4)));
typedef unsigned u32x4 __attribute__((ext_vector_type(4)));
typedef unsigned u32x2 __attribute__((ext_vector_type(2)));
typedef LAS const char* lds_cptr;
typedef LAS char* lds_ptr;

constexpr int BATCH = 8, SEQ = 2048, DM = 2048, MTOK = BATCH * SEQ, NPROJ = 4608, INC = 5124, FF = 8192, DEPTH = 2;
constexpr size_t MiB = (size_t)1 << 20;
constexpr size_t WS_WIN = 1 * MiB, WS_WOUT = 20 * MiB, WS_WFF1 = 28 * MiB, WS_WFF2 = 60 * MiB, WS_SMALL = 92 * MiB, WS_XN = 98 * MiB,
                 WS_PROJ = 162 * MiB, WS_MIX = 306 * MiB, WS_FFH = 162 * MiB, WS_END = 418 * MiB;
constexpr size_t SM_POOLWT = 0, SM_ROT = 128 * 1024, SM_LOGF = 640 * 1024, SM_RS = 896 * 1024, SM_SSP = 1024 * 1024;
constexpr int NPROJ_G = 4864;
constexpr int LDS_BYTES = 147456;
constexpr int NWAVES = 8, NTHR = 512;
constexpr float LN_EPS = 1e-6f;

typedef float f32x2_t __attribute__((ext_vector_type(2)));
typedef __bf16 bf16x2_t __attribute__((ext_vector_type(2)));
DEV unsigned pk2(float lo, float hi) { const f32x2_t v = {lo, hi}; const bf16x2_t b = __builtin_convertvector(v, bf16x2_t); return __builtin_bit_cast(unsigned, b); }
DEV float bflo(unsigned w) { return __uint_as_float(w << 16); }
DEV float bfhi(unsigned w) { return __uint_as_float(w & 0xffff0000u); }
DEV float ex2(float x) { return __builtin_amdgcn_exp2f(x); }
DEV float gelu_tanh(float x) { const float z2 = 2.3022081986f * (x + 0.044715f * x * x * x); return x * __builtin_amdgcn_rcpf(1.0f + ex2(-z2)); }
DEV float silu(float x) { return x * __builtin_amdgcn_rcpf(1.0f + ex2(-x * 1.4426950408889634f)); }
DEV float wave_sum(float v) {
#pragma unroll
    for (int o = 1; o < 64; o <<= 1) v += __shfl_xor(v, o);
    return v; }
DEV float red16(float v) { v += __shfl_xor(v, 1); v += __shfl_xor(v, 2); v += __shfl_xor(v, 4); v += __shfl_xor(v, 8); return v; }
DEV float redg(float v) { v += __shfl_xor(v, 16); v += __shfl_xor(v, 32); return v; }
DEV bf16x8 ld_row(lds_cptr base, int pitch, int row, int col) { return *(const LAS bf16x8*)(base + row * pitch + col * 2); }
DEV s16x4 ld_tr(lds_cptr p) { return __builtin_bit_cast(s16x4, __builtin_amdgcn_ds_read_tr16_b64_v4i16((LAS s16x4*)p)); }
DEV bf16x8 cat8(s16x4 a, s16x4 b) { return __builtin_shufflevector(a, b, 0, 1, 2, 3, 4, 5, 6, 7); }
DEV bf16x8 pack8(f32x4 a, f32x4 b) { u32x4 w; w.x = pk2(a[0], a[1]); w.y = pk2(a[2], a[3]); w.z = pk2(b[0], b[1]); w.w = pk2(b[2], b[3]); return __builtin_bit_cast(bf16x8, w); }
DEV f32x4 mfma16(bf16x8 a, bf16x8 b, f32x4 c) { return __builtin_amdgcn_mfma_f32_16x16x32_bf16(a, b, c, 0, 0, 0); }
#define FRESH_IDS int tid_l = threadIdx.x; asm volatile("" : "+v"(tid_l)); const int tid = tid_l, lane = tid & 63, wid = __builtin_amdgcn_readfirstlane(tid >> 6); (void)lane; (void)wid
#define LDS_WAIT() asm volatile("s_waitcnt lgkmcnt(0)" ::: "memory")

struct Args {
    const float *x, *norm_mix_g, *w_in, *fox_b_f, *pool_w, *pool_scale, *sgu_norm_g, *sgu_w_s, *sgu_b, *ret_norm_g, *w_out, *norm_mlp_g, *w_ff1, *w_ff2, *norm_final_g;
    float* out; unsigned char* ws;
};

DEV int win_srccol(int n) {
    if (n >= 4608) return (n - 4608 < 4) ? 3072 + (n - 4608) : -1;
    if (n < 3072) return n;
    if (n >= 3584) return n + 4;
    const int r = n - 3072, which = r >> 8, hh = (r >> 6) & 3, j = r & 63, oj = (j & 1) ? (j >> 1) + 32 : (j >> 1);
    return 3076 + which * 256 + hh * 64 + oj;
}
template <int MAP> DEV void transpose_item(const float* W, int ldw, int K, int nblk, bf16_t* WT, LAS float* scr, int item, int lane, const float* gk) {
    const int kb = item / nblk, nb = item - kb * nblk, k0 = 64 * kb, n0 = 32 * nb;
    const int sc = MAP ? win_srccol(n0 + (lane & 31)) : n0 + (lane & 31);
    const float* wp = W + (size_t)(k0 + (lane >> 5)) * ldw + (sc < 0 ? 0 : sc);
    float v[32];
#pragma unroll
    for (int i = 0; i < 32; ++i) v[i] = wp[(size_t)(2 * i) * ldw];
    const int c = lane & 7;
    f32x4 g0 = {1.f, 1.f, 1.f, 1.f}, g1 = {1.f, 1.f, 1.f, 1.f};
    if (gk) { g0 = *(const f32x4*)(gk + k0 + 8 * c); g1 = *(const f32x4*)(gk + k0 + 8 * c + 4); }
#pragma unroll
    for (int i = 0; i < 32; ++i) scr[(2 * i + (lane >> 5)) * 33 + (lane & 31)] = (MAP && sc < 0) ? 0.f : v[i];
    LDS_WAIT();
#pragma unroll
    for (int j = 0; j < 4; ++j) { const int n = (lane >> 3) + 8 * j; const LAS float* s = scr + (8 * c) * 33 + n;
        u32x4 o; o.x = pk2(s[0 * 33] * g0[0], s[1 * 33] * g0[1]); o.y = pk2(s[2 * 33] * g0[2], s[3 * 33] * g0[3]); o.z = pk2(s[4 * 33] * g1[0], s[5 * 33] * g1[1]); o.w = pk2(s[6 * 33] * g1[2], s[7 * 33] * g1[3]);
        *(u32x4*)(WT + (size_t)(n0 + n) * K + k0 + 8 * c) = o; }
    LDS_WAIT();
}
DEV void convert_layer(const Args& a, int layer, lds_ptr lds) {
    FRESH_IDS; const int G = gridDim.x, bid = blockIdx.x, gw = bid * NWAVES + wid, NGW = G * NWAVES, gtid = bid * NTHR + tid, NGT = G * NTHR;
    LAS float* scr = (LAS float*)(lds + wid * 8448);
    bf16_t* WinT = (bf16_t*)(a.ws + WS_WIN); bf16_t* WoutT = (bf16_t*)(a.ws + WS_WOUT); bf16_t* W1T = (bf16_t*)(a.ws + WS_WFF1); bf16_t* W2T = (bf16_t*)(a.ws + WS_WFF2);
    const float* win = a.w_in + (size_t)layer * DM * INC; const float* wout = a.w_out + (size_t)layer * DM * DM;
    const float* w1 = a.w_ff1 + (size_t)layer * DM * FF; const float* w2 = a.w_ff2 + (size_t)layer * FF * DM;
    constexpr int I_IN = (DM / 64) * (NPROJ_G / 32), I_OUT = (DM / 64) * (DM / 32), I_1 = (DM / 64) * (FF / 32), I_2 = (FF / 64) * (DM / 32);
    constexpr int NITEMS = I_IN + I_OUT + I_1 + I_2;
    for (int it = gw; it < NITEMS; it += NGW) {
        int r = it;
        if (r < I_IN) { transpose_item<1>(win, INC, DM, NPROJ_G / 32, WinT, scr, r, lane, a.norm_mix_g + layer * DM); continue; } r -= I_IN;
        if (r < I_OUT) { transpose_item<0>(wout, DM, DM, DM / 32, WoutT, scr, r, lane, nullptr); continue; } r -= I_OUT;
        if (r < I_1) { transpose_item<0>(w1, FF, DM, FF / 32, W1T, scr, r, lane, a.norm_mlp_g + layer * DM); continue; } r -= I_1;
        transpose_item<0>(w2, DM, FF, DM / 32, W2T, scr, r, lane, nullptr);
    }
    bf16_t* pwt = (bf16_t*)(a.ws + WS_SMALL + SM_POOLWT);
    const float* pw = a.pool_w + (size_t)layer * 4 * 128 * 128; const float* ps = a.pool_scale + (size_t)layer * 512;
    for (int e = gtid; e < 4 * 128 * 128; e += NGT) { const int g = e >> 14, d = (e >> 7) & 127, c = e & 127;
        const float v = pw[(g * 128 + c) * 128 + d] * ps[g * 128 + d]; pwt[e] = (bf16_t)(pk2(v, 0.f) & 0xffffu); }
}
DEV void rot_table(const Args& a) {
    FRESH_IDS; const int gtid = blockIdx.x * NTHR + tid, NGT = gridDim.x * NTHR;
    float* rot = (float*)(a.ws + WS_SMALL + SM_ROT);
    for (int e = gtid; e < SEQ * 32; e += NGT) { const int pos = e >> 5, i = e & 31;
        double inv = 1.0; for (int k = 0; k < i; ++k) inv *= 0.74989420933245582730;
        const double ang = (double)pos * inv;
        const double n = rint(ang * 0.63661977236758134308); const double y = ang - n * 1.57079632679489661923; const double y2 = y * y;
        const double sn = y * (1.0 + y2 * (-1.0 / 6 + y2 * (1.0 / 120 + y2 * (-1.0 / 5040 + y2 * (1.0 / 362880 + y2 * (-1.0 / 39916800))))));
        const double cs = 1.0 + y2 * (-0.5 + y2 * (1.0 / 24 + y2 * (-1.0 / 720 + y2 * (1.0 / 40320 + y2 * (-1.0 / 3628800 + y2 * (1.0 / 479001600))))));
        const int qd = ((int)n) & 3; double c, s;
        if (qd == 0) { c = cs; s = sn; } else if (qd == 1) { c = -sn; s = cs; } else if (qd == 2) { c = -cs; s = -sn; } else { c = sn; s = -cs; }
        rot[2 * e] = (float)c; rot[2 * e + 1] = (float)s; }
}

template <int MODE> DEV void norm_phase(const float* src, const float* gvec, bf16_t* xn, float* outf, float* rsout) {
    FRESH_IDS; const int gw = blockIdx.x * NWAVES + wid, NGW = gridDim.x * NWAVES;
    for (int m = gw; m < MTOK; m += NGW) {
        const f32x4* xr = (const f32x4*)(src + (size_t)m * DM) + lane;
        f32x4 v[8]; float s = 0.f;
#pragma unroll
        for (int j = 0; j < 8; ++j) { v[j] = xr[64 * j]; s += (v[j][0] * v[j][0] + v[j][1] * v[j][1]) + (v[j][2] * v[j][2] + v[j][3] * v[j][3]); }
        s = wave_sum(s);
        const float rs = 1.0f / sqrtf(s * (1.0f / DM) + LN_EPS);
        if (MODE == 2) { f32x4* o = (f32x4*)(outf + (size_t)m * DM) + lane;
#pragma unroll
            for (int j = 0; j < 8; ++j) { const f32x4 g = ((const f32x4*)gvec)[lane + 64 * j]; o[64 * j] = v[j] * rs * g; }
        } else { u32x2* o = (u32x2*)(xn + (size_t)m * DM) + lane;
#pragma unroll
            for (int j = 0; j < 8; ++j) { u32x2 w; w.x = pk2(v[j][0], v[j][1]); w.y = pk2(v[j][2], v[j][3]); o[64 * j] = w; }
            if (lane == 0) rsout[m] = rs; }
    }
}
DEV void rs_phase(const float* ssp, float* rsout) {
    FRESH_IDS; const int gtid = blockIdx.x * NTHR + tid, NGT = gridDim.x * NTHR;
    for (int m = gtid; m < MTOK; m += NGT) { const f32x4* p = (const f32x4*)(ssp + (size_t)m * 32); float s = 0.f;
#pragma unroll
        for (int j = 0; j < 8; ++j) { const f32x4 v = p[j]; s += (v[0] + v[1]) + (v[2] + v[3]); }
        rsout[m] = 1.0f / sqrtf(s * (1.0f / DM) + LN_EPS); }
}
#define XB_TMO      128
#define XB_XCNT(j)  (256  + 64 * (j))
#define XB_XSUB(j)  (1280 + 64 * (j))
#define XB_XGEN(j)  (2304 + 64 * (j))
#define XB_TOP      3328
#define XB_TOPGEN   3392
#define XCD_BAR_WORDS 3456
#define XB_SPIN_CAP (1u << 18)

__device__ __forceinline__ unsigned xb_ld(unsigned* p)              { return __hip_atomic_load(p, __ATOMIC_RELAXED, __HIP_MEMORY_SCOPE_AGENT); }
__device__ __forceinline__ unsigned xb_add(unsigned* p, unsigned v) { return __hip_atomic_fetch_add(p, v, __ATOMIC_RELAXED, __HIP_MEMORY_SCOPE_AGENT); }
__device__ __forceinline__ unsigned xb_xcc_id() { return (unsigned)__builtin_amdgcn_s_getreg((3 << 11) | 20) & 0xFu; }
#define XB_SPIN(cond, bar) do { unsigned _sp = 0; while (cond) { __builtin_amdgcn_s_sleep(1); \
    if ((++_sp & 255u) == 0u) { if (xb_ld(&(bar)[XB_TMO])) break; if (_sp > XB_SPIN_CAP) { atomicAdd(&(bar)[XB_TMO], 1u); break; } } } } while (0)

struct XcdBarrier {
    unsigned* bar; unsigned x;
    volatile LAS unsigned* st;
};

__device__ __forceinline__ XcdBarrier xcd_barrier_post(unsigned* bar, volatile LAS unsigned* st) {
    XcdBarrier b; b.bar = bar; b.x = xb_xcc_id(); b.st = st;
    if (threadIdx.x == 0) (void)xb_add(&bar[XB_XCNT(b.x)], 1u);
    return b;
}
__device__ __forceinline__ void xcd_barrier_complete(unsigned* bar, unsigned x, unsigned& nloc, unsigned& nx) {
    const unsigned G = gridDim.x * gridDim.y * gridDim.z;
    unsigned sum, cnt, mine, sp = 0u;
    for (;;) {
        sum = 0u; cnt = 0u; mine = 0u;
#pragma unroll
        for (unsigned j = 0; j < 16; ++j) { const unsigned c = xb_ld(&bar[XB_XCNT(j)]); sum += c; cnt += (c > 0u) ? 1u : 0u; mine = (j == x) ? c : mine; }
        if (sum == G) break;
        __builtin_amdgcn_s_sleep(1);
        if ((++sp & 255u) == 0u) { if (xb_ld(&bar[XB_TMO])) break; if (sp > XB_SPIN_CAP) { atomicAdd(&bar[XB_TMO], 1u); break; } }
    }
    nloc = mine > 0u ? mine : 1u; nx = cnt > 0u ? cnt : 1u;
}

__device__ __forceinline__ void xcd_barrier(const XcdBarrier& b) {
    asm volatile("s_waitcnt vmcnt(0)" ::: "memory");
    __syncthreads();
    if (threadIdx.x == 0) {
        unsigned* bar = b.bar;
        __builtin_amdgcn_s_waitcnt(0);
        unsigned nloc = b.st[0], nx = b.st[1];
        if (nloc == 0u) { xcd_barrier_complete(bar, b.x, nloc, nx); b.st[0] = nloc; b.st[1] = nx; }
        const unsigned old = xb_add(&bar[XB_XSUB(b.x)], 1u);
        const unsigned gen = old / nloc;
        if (old + 1u == (gen + 1u) * nloc) {
            __builtin_amdgcn_fence(__ATOMIC_RELEASE, "agent");
            asm volatile("s_waitcnt vmcnt(0)" ::: "memory");
            const unsigned og = xb_add(&bar[XB_TOP], 1u);
            const unsigned tg = og / nx;
            if (og + 1u == (tg + 1u) * nx) xb_add(&bar[XB_TOPGEN], 1u);
            else XB_SPIN(xb_ld(&bar[XB_TOPGEN]) == tg, bar);
            __builtin_amdgcn_fence(__ATOMIC_ACQUIRE, "agent");
            xb_add(&bar[XB_XGEN(b.x)], 1u);
            asm volatile("s_waitcnt vmcnt(0)" ::: "memory");
        } else {
            XB_SPIN(xb_ld(&bar[XB_XGEN(b.x)]) == gen, bar);
            __builtin_amdgcn_fence(__ATOMIC_ACQUIRE, "agent");
            asm volatile("s_waitcnt vmcnt(0)" ::: "memory");
        }
    }
    __syncthreads();
}
#define LDS_BARRIER() do { asm volatile("s_waitcnt lgkmcnt(0)" ::: "memory"); __builtin_amdgcn_s_barrier(); asm volatile("" ::: "memory"); } while (0)
constexpr int P128 = 272, P64 = 144;
constexpr int PV = 288, PK = 160;

DEV void fox_tile(lds_cptr Kp, lds_cptr Vp, LAS const float* cs, int key0, int tq, float cq2, bool diag, const bf16x8 (&qf)[4], f32x4 (&o)[8], float& mrun, float& lsum, int g, int r16, int q4, int p4) {
    f32x4 sa[4];
    bf16x8 kf[16]; f32x4 ckv[4];
#pragma unroll
    for (int st = 0; st < 4; ++st)
#pragma unroll
        for (int ks = 0; ks < 4; ++ks) kf[st * 4 + ks] = ld_row(Kp, P128, 16 * st + r16, 32 * ks + 8 * g);
#pragma unroll
    for (int st = 0; st < 4; ++st) ckv[st] = *(const LAS f32x4*)(cs + key0 + 16 * st + 4 * g);
    __builtin_amdgcn_sched_barrier(0);
#pragma unroll
    for (int st = 0; st < 4; ++st) { sa[st] = cq2 - ckv[st];
#pragma unroll
        for (int ks = 0; ks < 4; ++ks) sa[st] = mfma16(kf[st * 4 + ks], qf[ks], sa[st]); }
    float mx = -INFINITY;
#pragma unroll
    for (int st = 0; st < 4; ++st) {
#pragma unroll
        for (int j = 0; j < 4; ++j) { float l = sa[st][j]; if (diag && (key0 + 16 * st + 4 * g + j > tq)) l = -INFINITY; sa[st][j] = l; mx = fmaxf(mx, l); } }
    mx = fmaxf(mx, __shfl_xor(mx, 16)); mx = fmaxf(mx, __shfl_xor(mx, 32));
    if (__builtin_amdgcn_ballot_w64(mx > mrun) != 0ull) {
        const float mnew = fmaxf(mrun, mx); const float alpha = ex2(mrun - mnew); mrun = mnew;
        lsum = lsum * alpha;
#pragma unroll
        for (int dt = 0; dt < 8; ++dt) o[dt] = o[dt] * alpha;
    } else if (__builtin_amdgcn_ballot_w64(mx - mrun > -140.0f) == 0ull) return;
    float rsum = 0.f;
#pragma unroll
    for (int st = 0; st < 4; ++st)
#pragma unroll
        for (int j = 0; j < 4; ++j) { const float p = ex2(sa[st][j] - mrun); sa[st][j] = p; rsum += p; }
    lsum += rsum;
    bf16x8 pf[2]; pf[0] = pack8(sa[0], sa[1]); pf[1] = pack8(sa[2], sa[3]);
#pragma unroll
    for (int h = 0; h < 2; ++h) { s16x4 vf[4][2][2];
#pragma unroll
        for (int d4 = 0; d4 < 4; ++d4)
#pragma unroll
            for (int i = 0; i < 2; ++i) { lds_cptr vp = Vp + (32 * i + 4 * g + q4) * PV + (16 * (4 * h + d4) + 4 * p4) * 2; vf[d4][i][0] = ld_tr(vp); vf[d4][i][1] = ld_tr(vp + 16 * PV); }
        __builtin_amdgcn_sched_barrier(0);
#pragma unroll
        for (int d4 = 0; d4 < 4; ++d4)
#pragma unroll
            for (int i = 0; i < 2; ++i) o[4 * h + d4] = mfma16(cat8(vf[d4][i][0], vf[d4][i][1]), pf[i], o[4 * h + d4]); }
}
DEV void fox_item(lds_ptr lds, const bf16_t* PROJ, const float* LOGF, bf16_t* MIX, int b, int hd, int qb) {
    FRESH_IDS;
    const int g = lane >> 4, r16 = lane & 15, q4 = r16 >> 2, p4 = r16 & 3;
    const int t0 = qb * 128, nkeys = t0 + 128, ntiles = nkeys >> 6;
    LAS float* cs = (LAS float*)(lds + 71680); LAS float* wtot = (LAS float*)(lds + 79872);
    const int tq = t0 + 16 * wid + r16;
    bf16x8 qf[4];
    { const bf16_t* qp = PROJ + (size_t)(b * SEQ + tq) * NPROJ + 1536 + hd * 128 + 8 * g;
#pragma unroll
      for (int ks = 0; ks < 4; ++ks) { const u32x4 w = *(const u32x4*)(qp + 32 * ks); const float S2 = 0.08838834764831845f * 1.4426950408889634f;
          u32x4 r; r.x = pk2(bflo(w.x) * S2, bfhi(w.x) * S2); r.y = pk2(bflo(w.y) * S2, bfhi(w.y) * S2); r.z = pk2(bflo(w.z) * S2, bfhi(w.z) * S2); r.w = pk2(bflo(w.w) * S2, bfhi(w.w) * S2);
          qf[ks] = __builtin_bit_cast(bf16x8, r); } }
    {
        const int s0 = tid * 4; float x[4];
#pragma unroll
        for (int e = 0; e < 4; ++e) x[e] = (s0 + e < nkeys) ? LOGF[(size_t)(b * SEQ + s0 + e) * 4 + hd] : 0.f;
        x[1] += x[0]; x[2] += x[1]; x[3] += x[2];
        const float tot = x[3]; float inc = tot;
#pragma unroll
        for (int o = 1; o < 64; o <<= 1) { const float y = __shfl_up(inc, o); if (lane >= o) inc += y; }
        if (lane == 63) wtot[wid] = inc;
        __syncthreads();
        float base = inc - tot; for (int w2 = 0; w2 < wid; ++w2) base += wtot[w2];
        const float L2E = 1.4426950408889634f;
        *(LAS f32x4*)(cs + s0) = (f32x4){(x[0] + base) * L2E, (x[1] + base) * L2E, (x[2] + base) * L2E, (x[3] + base) * L2E};
        __syncthreads();
    }
    const float cq2 = cs[tq];
    u32x4 kr0[2], vr0[2], kr1[2], vr1[2];
#define FOX_GLOAD(KR, VR, kt) do { _Pragma("unroll") for (int it = 0; it < 2; ++it) { const int i = tid + NTHR * it, row = i >> 4, ch = i & 15; \
        const bf16_t* rp = PROJ + (size_t)(b * SEQ + (kt) * 64 + row) * NPROJ + hd * 128 + ch * 8; KR[it] = *(const u32x4*)(rp + 2048); VR[it] = *(const u32x4*)(rp + 2560); } } while (0)
#define FOX_LWRITE(KR, VR, buf) do { _Pragma("unroll") for (int it = 0; it < 2; ++it) { const int i = tid + NTHR * it, row = i >> 4, ch = i & 15; \
        *(LAS u32x4*)(lds + (buf) * 17408 + row * P128 + ch * 16) = KR[it]; *(LAS u32x4*)(lds + 34816 + (buf) * 18432 + row * PV + ch * 16) = VR[it]; } } while (0)
    f32x4 o[8];
#pragma unroll
    for (int dt = 0; dt < 8; ++dt) o[dt] = (f32x4){0.f, 0.f, 0.f, 0.f};
    float mrun = -INFINITY, lsum = 0.f;
    FOX_GLOAD(kr0, vr0, ntiles - 1); FOX_GLOAD(kr1, vr1, ntiles - 2); FOX_LWRITE(kr0, vr0, 0); if (2 < ntiles) FOX_GLOAD(kr0, vr0, ntiles - 3);
#define FOX_STEP(s, KRW, VRW) do { \
        LDS_BARRIER(); \
        { const int kt_ = ntiles - 1 - (s); \
          if (kt_ * 64 <= t0 + 16 * wid + 15) fox_tile(lds + ((s) & 1) * 17408, lds + 34816 + ((s) & 1) * 18432, cs, kt_ * 64, tq, cq2, kt_ * 64 + 63 > t0 + 16 * wid, qf, o, mrun, lsum, g, r16, q4, p4); } \
        if ((s) + 1 < ntiles) FOX_LWRITE(KRW, VRW, ((s) + 1) & 1); \
        if ((s) + 3 < ntiles) FOX_GLOAD(KRW, VRW, ntiles - 1 - ((s) + 3)); } while (0)
    for (int kt = 0; kt < ntiles; kt += 2) { FOX_STEP(kt, kr1, vr1); FOX_STEP(kt + 1, kr0, vr0); }
#undef FOX_STEP
#undef FOX_GLOAD
#undef FOX_LWRITE
    lsum = redg(lsum); const float inv = 1.0f / lsum;
    bf16_t* op = MIX + (size_t)(b * SEQ + tq) * DM + 1024 + hd * 128 + 4 * g;
#pragma unroll
    for (int dt = 0; dt < 8; ++dt) { u32x2 w; w.x = pk2(o[dt][0] * inv, o[dt][1] * inv); w.y = pk2(o[dt][2] * inv, o[dt][3] * inv); *(u32x2*)(op + 16 * dt) = w; }
    __syncthreads();
}

DEV void sgu_item(lds_ptr lds, const bf16_t* PROJ, bf16_t* MIX, const float* ng, const float* w_s, const float* b_s, int b, int c, int hd) {
    FRESH_IDS;
    const int g = lane >> 4, r16 = lane & 15, q4 = r16 >> 2, p4 = r16 & 3;
    const size_t R0 = (size_t)b * SEQ + c * 128;
    lds_ptr Vimg = lds, Wimg = lds + 36864;
#pragma unroll
    for (int it = 0; it < 4; ++it) { const int i = tid + NTHR * it, row = i >> 4, ch = i & 15;
        const u32x4 raw = *(const u32x4*)(PROJ + (R0 + row) * NPROJ + 1024 + hd * 128 + ch * 8);
        float x[8]; x[0] = bflo(raw.x); x[1] = bfhi(raw.x); x[2] = bflo(raw.y); x[3] = bfhi(raw.y); x[4] = bflo(raw.z); x[5] = bfhi(raw.z); x[6] = bflo(raw.w); x[7] = bfhi(raw.w);
        float s = 0.f;
#pragma unroll
        for (int e = 0; e < 8; ++e) { x[e] = gelu_tanh(x[e]); s += x[e]; }
        const float mean = red16(s) * (1.0f / 128.0f); float v = 0.f;
#pragma unroll
        for (int e = 0; e < 8; ++e) { x[e] -= mean; v += x[e] * x[e]; }
        const float rstd = 1.0f / sqrtf(red16(v) * (1.0f / 128.0f) + LN_EPS);
        const f32x4 g0 = *(const f32x4*)(ng + hd * 128 + ch * 8), g1 = *(const f32x4*)(ng + hd * 128 + ch * 8 + 4);
        u32x4 w; w.x = pk2(x[0] * rstd * g0[0], x[1] * rstd * g0[1]); w.y = pk2(x[2] * rstd * g0[2], x[3] * rstd * g0[3]);
        w.z = pk2(x[4] * rstd * g1[0], x[5] * rstd * g1[1]); w.w = pk2(x[6] * rstd * g1[2], x[7] * rstd * g1[3]);
        *(LAS u32x4*)(Vimg + row * PV + ch * 16) = w; }
#pragma unroll
    for (int it = 0; it < 4; ++it) { const int i = tid + NTHR * it, t = i >> 4, ch = i & 15;
        const float* wp = w_s + (size_t)(hd * 128 + t) * 128 + ch * 8; const f32x4 a0 = *(const f32x4*)wp, a1 = *(const f32x4*)(wp + 4);
        float x[8] = {a0[0], a0[1], a0[2], a0[3], a1[0], a1[1], a1[2], a1[3]};
#pragma unroll
        for (int e = 0; e < 8; ++e) if (ch * 8 + e > t) x[e] = 0.f;
        u32x4 w; w.x = pk2(x[0], x[1]); w.y = pk2(x[2], x[3]); w.z = pk2(x[4], x[5]); w.w = pk2(x[6], x[7]);
        *(LAS u32x4*)(Wimg + t * P128 + ch * 16) = w; }
    __syncthreads();
    f32x4 acc[8];
#pragma unroll
    for (int dt = 0; dt < 8; ++dt) acc[dt] = (f32x4){0.f, 0.f, 0.f, 0.f};
    const int tl = 16 * wid + r16;
    u32x2 urv[8];
    { const bf16_t* upl = PROJ + (R0 + tl) * NPROJ + 512 + hd * 128 + 4 * g;
#pragma unroll
      for (int dt = 0; dt < 8; ++dt) urv[dt] = *(const u32x2*)(upl + 16 * dt); }
    const float bias = b_s[hd * 128 + tl];
#pragma unroll
    for (int ks = 0; ks < 4; ++ks) if (32 * ks <= 16 * wid + 15) {
        lds_cptr wp = Wimg + tl * P128 + (32 * ks + 4 * g) * 2;
        const bf16x8 bfr = cat8(*(const LAS s16x4*)wp, *(const LAS s16x4*)(wp + 32));
        s16x4 vf[8][2];
#pragma unroll
        for (int dt = 0; dt < 8; ++dt) { lds_cptr vp = Vimg + (32 * ks + 4 * g + q4) * PV + (16 * dt + 4 * p4) * 2; vf[dt][0] = ld_tr(vp); vf[dt][1] = ld_tr(vp + 16 * PV); }
        __builtin_amdgcn_sched_barrier(0);
#pragma unroll
        for (int dt = 0; dt < 8; ++dt) acc[dt] = mfma16(cat8(vf[dt][0], vf[dt][1]), bfr, acc[dt]); }
    bf16_t* op = MIX + (R0 + tl) * DM + 512 + hd * 128 + 4 * g;
#pragma unroll
    for (int dt = 0; dt < 8; ++dt) { const u32x2 ur = urv[dt];
        const float u0 = gelu_tanh(bflo(ur.x)), u1 = gelu_tanh(bfhi(ur.x)), u2 = gelu_tanh(bflo(ur.y)), u3 = gelu_tanh(bfhi(ur.y));
        u32x2 w; w.x = pk2(u0 * (acc[dt][0] + bias), u1 * (acc[dt][1] + bias)); w.y = pk2(u2 * (acc[dt][2] + bias), u3 * (acc[dt][3] + bias)); *(u32x2*)(op + 16 * dt) = w; }
    __syncthreads();
}

template <int WIN> DEV void pool_stage(lds_ptr Pimg, const bf16_t* PROJ, size_t R0, int c, int gi, int tid) {
#pragma unroll 1
    for (int it = 0; it < 4; ++it) { const int i = tid + NTHR * it, row = i >> 4, ch = i & 15, t = c * 128 + row;
        const bf16_t* rp = PROJ + (R0 + row) * NPROJ + gi * 128 + ch * 8;
        u32x4 raw[WIN];
#pragma unroll
        for (int j = 0; j < WIN; ++j) { raw[j] = (u32x4){0u, 0u, 0u, 0u}; if (t - j >= 0) raw[j] = *(const u32x4*)(rp - (size_t)j * NPROJ); }
        float s[8];
#pragma unroll
        for (int e = 0; e < 8; ++e) s[e] = 0.f;
#pragma unroll
        for (int j = 0; j < WIN; ++j) { s[0] += bflo(raw[j].x); s[1] += bfhi(raw[j].x); s[2] += bflo(raw[j].y); s[3] += bfhi(raw[j].y); s[4] += bflo(raw[j].z); s[5] += bfhi(raw[j].z); s[6] += bflo(raw[j].w); s[7] += bfhi(raw[j].w); }
        const float rc = __builtin_amdgcn_rcpf((float)min(t + 1, WIN));
        u32x4 w; w.x = pk2(s[0] * rc - bflo(raw[0].x), s[1] * rc - bfhi(raw[0].x)); w.y = pk2(s[2] * rc - bflo(raw[0].y), s[3] * rc - bfhi(raw[0].y));
        w.z = pk2(s[4] * rc - bflo(raw[0].z), s[5] * rc - bfhi(raw[0].z)); w.w = pk2(s[6] * rc - bflo(raw[0].w), s[7] * rc - bfhi(raw[0].w));
        *(LAS u32x4*)(Pimg + row * P128 + ch * 16) = w; }
}
DEV void pool_item(lds_ptr lds, const bf16_t* PROJ, bf16_t* MIX, const bf16_t* pwt, int b, int c, int gi) {
    FRESH_IDS;
    const int g = lane >> 4, r16 = lane & 15;
    const size_t R0 = (size_t)b * SEQ + c * 128;
    lds_ptr Pimg = lds, Wimg = lds + 34816;
    switch (gi) { case 0: pool_stage<2>(Pimg, PROJ, R0, c, gi, tid); break; case 1: pool_stage<4>(Pimg, PROJ, R0, c, gi, tid); break;
                  case 2: pool_stage<8>(Pimg, PROJ, R0, c, gi, tid); break; default: pool_stage<16>(Pimg, PROJ, R0, c, gi, tid); break; }
#pragma unroll
    for (int it = 0; it < 4; ++it) { const int i = tid + NTHR * it, row = i >> 4, ch = i & 15;
        *(LAS u32x4*)(Wimg + row * P128 + ch * 16) = *(const u32x4*)(pwt + (size_t)gi * 16384 + row * 128 + ch * 8); }
    __syncthreads();
    f32x4 acc[8];
#pragma unroll
    for (int dt = 0; dt < 8; ++dt) acc[dt] = (f32x4){0.f, 0.f, 0.f, 0.f};
    const int tl = 16 * wid + r16;
#pragma unroll
    for (int ks = 0; ks < 4; ++ks) { const bf16x8 bfr = ld_row(Pimg, P128, tl, 32 * ks + 8 * g); bf16x8 wf[8];
#pragma unroll
        for (int dt = 0; dt < 8; ++dt) wf[dt] = ld_row(Wimg, P128, 16 * dt + r16, 32 * ks + 8 * g);
        __builtin_amdgcn_sched_barrier(0);
#pragma unroll
        for (int dt = 0; dt < 8; ++dt) acc[dt] = mfma16(wf[dt], bfr, acc[dt]); }
    bf16_t* op = MIX + (R0 + tl) * DM + gi * 128 + 4 * g;
#pragma unroll
    for (int dt = 0; dt < 8; ++dt) { u32x2 w; w.x = pk2(acc[dt][0], acc[dt][1]); w.y = pk2(acc[dt][2], acc[dt][3]); *(u32x2*)(op + 16 * dt) = w; }
    __syncthreads();
}

DEV void ret_item(lds_ptr lds, const bf16_t* PROJ, bf16_t* MIX, const float* ng, int b, int hd, int c) {
    FRESH_IDS;
    const int g = lane >> 4, r16 = lane & 15, q4 = r16 >> 2, p4 = r16 & 3;
    const float lg2 = __log2f(1.0f - ex2(-5.0f - (float)hd));
    const size_t R0 = (size_t)b * SEQ + c * 128;
    const int l = 16 * wid + r16;
    bf16x8 qf[2];
    { const bf16_t* qp = PROJ + (R0 + l) * NPROJ + 3072 + hd * 64 + 8 * g; qf[0] = *(const bf16x8*)qp; qf[1] = *(const bf16x8*)(qp + 32); }
    lds_ptr Rt = lds + 114688;
    u32x4 kr0[2], vr0[4], kr1[2], vr1[4];
#define RET_GLOAD(KR, VR, j) do { const size_t rb = (size_t)b * SEQ + (j) * 128; \
        _Pragma("unroll") for (int it = 0; it < 2; ++it) { const int i = tid + NTHR * it, row = i >> 3, ch = i & 7; KR[it] = *(const u32x4*)(PROJ + (rb + row) * NPROJ + 3328 + hd * 64 + ch * 8); } \
        _Pragma("unroll") for (int it = 0; it < 4; ++it) { const int i = tid + NTHR * it, row = i >> 4, ch = i & 15; VR[it] = *(const u32x4*)(PROJ + (rb + row) * NPROJ + 3584 + hd * 128 + ch * 8); } } while (0)
#define RET_LWRITE(KR, VR, j, buf) do { \
        _Pragma("unroll") for (int it = 0; it < 2; ++it) { const int i = tid + NTHR * it, row = i >> 3, ch = i & 7; u32x4 w = KR[it]; \
            if ((j) < c) { const float f = ex2(lg2 * (float)((c - (j)) * 128 - 1 - row)); \
                w.x = pk2(bflo(w.x) * f, bfhi(w.x) * f); w.y = pk2(bflo(w.y) * f, bfhi(w.y) * f); w.z = pk2(bflo(w.z) * f, bfhi(w.z) * f); w.w = pk2(bflo(w.w) * f, bfhi(w.w) * f); } \
            *(LAS u32x4*)(lds + (buf) * 20480 + row * PK + ch * 16) = w; } \
        _Pragma("unroll") for (int it = 0; it < 4; ++it) { const int i = tid + NTHR * it, row = i >> 4, ch = i & 15; *(LAS u32x4*)(lds + 40960 + (buf) * 36864 + row * PV + ch * 16) = VR[it]; } } while (0)
    const int dtl = wid & 3, eb = (wid >> 2) * 4;
    f32x4 sacc[4];
#pragma unroll
    for (int et = 0; et < 4; ++et) sacc[et] = (f32x4){0.f, 0.f, 0.f, 0.f};
    RET_GLOAD(kr0, vr0, 0); if (c >= 1) RET_GLOAD(kr1, vr1, 1); RET_LWRITE(kr0, vr0, 0, 0); if (c >= 2) RET_GLOAD(kr0, vr0, 2);
#define RET_STEP(j, KRW, VRW) do { \
        LDS_BARRIER(); \
        { lds_cptr Kp = lds + ((j) & 1) * 20480; lds_cptr Vp = lds + 40960 + ((j) & 1) * 36864; \
          _Pragma("unroll") for (int k2 = 0; k2 < 2; ++k2) { s16x4 af[2][2], vf[2][4][2]; \
            _Pragma("unroll") for (int kk = 0; kk < 2; ++kk) { const int ks = 2 * k2 + kk; lds_cptr kp = Kp + (32 * ks + 4 * g + q4) * PK + (16 * dtl + 4 * p4) * 2; af[kk][0] = ld_tr(kp); af[kk][1] = ld_tr(kp + 16 * PK); \
                _Pragma("unroll") for (int et = 0; et < 4; ++et) { lds_cptr vp = Vp + (32 * ks + 4 * g + q4) * PV + (16 * (eb + et) + 4 * p4) * 2; vf[kk][et][0] = ld_tr(vp); vf[kk][et][1] = ld_tr(vp + 16 * PV); } } \
            __builtin_amdgcn_sched_barrier(0); \
            _Pragma("unroll") for (int kk = 0; kk < 2; ++kk) _Pragma("unroll") for (int et = 0; et < 4; ++et) sacc[et] = mfma16(cat8(af[kk][0], af[kk][1]), cat8(vf[kk][et][0], vf[kk][et][1]), sacc[et]); } } \
        RET_LWRITE(KRW, VRW, (j) + 1, ((j) + 1) & 1); \
        if ((j) + 3 <= c) RET_GLOAD(KRW, VRW, (j) + 3); } while (0)
    for (int j = 0; j < c; j += 2) { RET_STEP(j, kr1, vr1); if (j + 1 < c) RET_STEP(j + 1, kr0, vr0); }
#undef RET_STEP
#undef RET_GLOAD
#undef RET_LWRITE
#pragma unroll
    for (int et = 0; et < 4; ++et) { u32x2 w; w.x = pk2(sacc[et][0], sacc[et][1]); w.y = pk2(sacc[et][2], sacc[et][3]);
        *(LAS u32x2*)(Rt + (16 * (eb + et) + r16) * P64 + (16 * dtl + 4 * g) * 2) = w; }
    __syncthreads();
    f32x4 y[8];
#pragma unroll
    for (int et = 0; et < 8; ++et) y[et] = (f32x4){0.f, 0.f, 0.f, 0.f};
    if (c > 0) {
        bf16x8 rf[16];
#pragma unroll
        for (int et = 0; et < 8; ++et)
#pragma unroll
            for (int ks = 0; ks < 2; ++ks) rf[et * 2 + ks] = ld_row(Rt, P64, 16 * et + r16, 32 * ks + 8 * g);
        __builtin_amdgcn_sched_barrier(0);
#pragma unroll
        for (int et = 0; et < 8; ++et)
#pragma unroll
            for (int ks = 0; ks < 2; ++ks) y[et] = mfma16(rf[et * 2 + ks], qf[ks], y[et]);
        const float xi = ex2(lg2 * (float)(l + 1));
#pragma unroll
        for (int et = 0; et < 8; ++et) y[et] = y[et] * xi;
    }
    lds_cptr Kp = lds + (c & 1) * 20480; lds_cptr Vp = lds + 40960 + (c & 1) * 36864;
    u32x2 grv[8]; f32x4 gnv[8];
    { const bf16_t* gpl = PROJ + (R0 + l) * NPROJ + 4096 + hd * 128 + 4 * g;
#pragma unroll
      for (int et = 0; et < 8; ++et) { grv[et] = *(const u32x2*)(gpl + 16 * et); gnv[et] = *(const f32x4*)(ng + hd * 128 + 16 * et + 4 * g); } }
    for (int i = 0; i <= (wid >> 1); ++i) {
        f32x4 pa[2];
#pragma unroll
        for (int h2 = 0; h2 < 2; ++h2) { const int mt = 2 * i + h2; pa[h2] = (f32x4){0.f, 0.f, 0.f, 0.f};
            if (mt <= wid) {
#pragma unroll
                for (int ks = 0; ks < 2; ++ks) pa[h2] = mfma16(ld_row(Kp, PK, 16 * mt + r16, 32 * ks + 8 * g), qf[ks], pa[h2]);
#pragma unroll
                for (int r = 0; r < 4; ++r) { const int dl = l - (16 * mt + 4 * g + r); pa[h2][r] = (dl >= 0) ? pa[h2][r] * ex2(lg2 * (float)dl) : 0.f; } } }
        const bf16x8 pf = pack8(pa[0], pa[1]);
        s16x4 vf[8][2];
#pragma unroll
        for (int et = 0; et < 8; ++et) { lds_cptr vp = Vp + (32 * i + 4 * g + q4) * PV + (16 * et + 4 * p4) * 2; vf[et][0] = ld_tr(vp); vf[et][1] = ld_tr(vp + 16 * PV); }
        __builtin_amdgcn_sched_barrier(0);
#pragma unroll
        for (int et = 0; et < 8; ++et) y[et] = mfma16(cat8(vf[et][0], vf[et][1]), pf, y[et]);
    }
    float s = 0.f;
#pragma unroll
    for (int et = 0; et < 8; ++et) s += (y[et][0] + y[et][1]) + (y[et][2] + y[et][3]);
    const float mu = redg(s) * (1.0f / 128.0f); float v = 0.f;
#pragma unroll
    for (int et = 0; et < 8; ++et) { y[et] = y[et] - mu; v += (y[et][0] * y[et][0] + y[et][1] * y[et][1]) + (y[et][2] * y[et][2] + y[et][3] * y[et][3]); }
    const float rstd = 1.0f / sqrtf(redg(v) * (1.0f / 128.0f) + LN_EPS);
    bf16_t* op = MIX + (R0 + l) * DM + 1536 + hd * 128 + 4 * g;
#pragma unroll
    for (int et = 0; et < 8; ++et) { const u32x2 gr = grv[et]; const f32x4 gn = gnv[et];
        u32x2 w; w.x = pk2(silu(bflo(gr.x)) * (y[et][0] * rstd * gn[0]), silu(bfhi(gr.x)) * (y[et][1] * rstd * gn[1]));
        w.y = pk2(silu(bflo(gr.y)) * (y[et][2] * rstd * gn[2]), silu(bfhi(gr.y)) * (y[et][3] * rstd * gn[3])); *(u32x2*)(op + 16 * et) = w; }
    __syncthreads();
}
#ifndef PH
#define PH 0xFFFF
#endif
__global__ void __launch_bounds__(NTHR, 2) hybrid_fwd(Args a) {
    extern __shared__ __attribute__((aligned(16))) unsigned char lds_raw[];
    cg::grid_group grid = cg::this_grid();
    lds_ptr lds = (lds_ptr)lds_raw;
    const int G = gridDim.x, bid = blockIdx.x;
    bf16_t* WinT = (bf16_t*)(a.ws + WS_WIN); bf16_t* WoutT = (bf16_t*)(a.ws + WS_WOUT); bf16_t* W1T = (bf16_t*)(a.ws + WS_WFF1); bf16_t* W2T = (bf16_t*)(a.ws + WS_WFF2);
    bf16_t* XN = (bf16_t*)(a.ws + WS_XN); bf16_t* PROJ = (bf16_t*)(a.ws + WS_PROJ); bf16_t* MIX = (bf16_t*)(a.ws + WS_MIX); bf16_t* FFH = (bf16_t*)(a.ws + WS_FFH);
    const bf16_t* PWT = (const bf16_t*)(a.ws + WS_SMALL + SM_POOLWT); const float* ROT = (const float*)(a.ws + WS_SMALL + SM_ROT); float* LOGF = (float*)(a.ws + WS_SMALL + SM_LOGF);
    float* RS = (float*)(a.ws + WS_SMALL + SM_RS); float* SSP = (float*)(a.ws + WS_SMALL + SM_SSP);
    volatile LAS unsigned* MISC = (volatile LAS unsigned*)(lds + 147200);
    unsigned* bar = (unsigned*)a.ws;
    { const int t0_ = threadIdx.x; if (t0_ < 16) MISC[t0_] = 0u; __syncthreads(); }
    if (a.ws == nullptr) grid.sync();
    const XcdBarrier xb = xcd_barrier_post(bar, MISC + 8);

#if PH & 1
    convert_layer(a, 0, lds);
    rot_table(a);
    norm_phase<0>(a.x, nullptr, XN, nullptr, RS);
#endif
    xcd_barrier(xb);

#pragma unroll 1
    for (int layer = 0; layer < DEPTH; ++layer) {
#if PH & 2
        { pg8::Gemm gm{XN, WinT, MTOK, NPROJ_G, DM}; pg8::RsOrder S; S.init(MTOK, NPROJ_G, G, bid); S.rs = RS;
          pg8::EpiProj E{PROJ, ROT, a.fox_b_f + layer * 4, LOGF};
          pg8::gemm_phase<pg8::EpiProj, pg8::RsOrder, true, true>((PG8_LAS unsigned char*)lds, gm, S, E); }
#endif
        xcd_barrier(xb);
#if PH & 4
        {
            const float* sg = a.sgu_norm_g + layer * 512; const float* sw = a.sgu_w_s + (size_t)layer * 4 * 128 * 128; const float* sb = a.sgu_b + layer * 512; const float* rg = a.ret_norm_g + layer * 512;
#pragma unroll 1
            for (int it0 = bid; it0 < 256; it0 += G) { const int it = (G == 256) ? (((it0 & 7) << 5) | (it0 >> 3)) : it0;
                const int b = it >> 5, hd = (it >> 3) & 3, x = it & 7;
#pragma unroll 1
                for (int rep = 0; rep < 2; ++rep) fox_item(lds, PROJ, LOGF, MIX, b, hd, rep ? x : 15 - x);
#pragma unroll 1
                for (int rep = 0; rep < 2; ++rep) ret_item(lds, PROJ, MIX, rg, b, hd, rep ? x : 15 - x); }
#pragma unroll 1
            for (int it0 = bid; it0 < 512; it0 += G) { int b, c, hd, half;
                if (G == 256) { const int idx = ((it0 & 255) >> 3) + 32 * (it0 >> 8); b = it0 & 7; c = idx >> 2; hd = idx & 3; half = it0 >> 8; }
                else { b = it0 >> 6; c = (it0 >> 2) & 15; hd = it0 & 3; half = (it0 >> 8) & 1; }
                sgu_item(lds, PROJ, MIX, sg, sw, sb, b, c, hd);
                pool_item(lds, PROJ, MIX, PWT, b, c, half ? 3 - hd : hd); }
        }
#endif
        xcd_barrier(xb);
#if PH & 8
        { pg8::Gemm gm{MIX, WoutT, MTOK, DM, DM}; pg8::StaticOrder S; S.init(MTOK, DM, G, bid);
          pg8::EpiResid<true> E{layer == 0 ? a.x : a.out, a.out, XN, SSP, DM};
          pg8::gemm_phase<pg8::EpiResid<true>, pg8::StaticOrder, true, true>((PG8_LAS unsigned char*)lds, gm, S, E); }
#endif
        xcd_barrier(xb);
        rs_phase(SSP, RS);
        xcd_barrier(xb);
#if PH & 16
        { pg8::Gemm gm{XN, W1T, MTOK, FF, DM}; pg8::RsOrder S; S.init(MTOK, FF, G, bid); S.rs = RS;
          pg8::EpiRelu2 E{FFH, FF};
          pg8::gemm_phase<pg8::EpiRelu2, pg8::RsOrder, true, true>((PG8_LAS unsigned char*)lds, gm, S, E); }
#endif
        xcd_barrier(xb);
#if PH & 32
        { pg8::Gemm gm{FFH, W2T, MTOK, DM, FF}; pg8::StaticOrder S; S.init(MTOK, DM, G, bid);
          if (layer + 1 < DEPTH) { pg8::EpiResid<true> E{a.out, a.out, XN, SSP, DM};
            pg8::gemm_phase<pg8::EpiResid<true>, pg8::StaticOrder, true, true>((PG8_LAS unsigned char*)lds, gm, S, E); }
          else { pg8::EpiResid<false> E{a.out, a.out, XN, SSP, DM};
            pg8::gemm_phase<pg8::EpiResid<false>, pg8::StaticOrder, true, true>((PG8_LAS unsigned char*)lds, gm, S, E); } }
#endif
        xcd_barrier(xb);
        if (layer + 1 < DEPTH) {
            convert_layer(a, layer + 1, lds);
            rs_phase(SSP, RS);
            xcd_barrier(xb);
        } else {
            norm_phase<2>(a.out, a.norm_final_g, nullptr, a.out, nullptr);
        }
    }
}

extern "C" void kernel_launch(void* const* d_in, const int* in_sizes, int n_in, void* d_out, int out_size, void* d_ws, size_t ws_size, hipStream_t stream) {
    static int grid = 0;
    if (grid == 0) {
        if (n_in != 15 || out_size != MTOK * DM || ws_size < WS_END) { fprintf(stderr, "kernel_launch: unexpected problem (n_in %d, out %d, ws %zu)\n", n_in, out_size, ws_size); grid = -1; return; }
        int dev = 0, cus = 0, per_cu = 0;
        (void)hipGetDevice(&dev); (void)hipDeviceGetAttribute(&cus, hipDeviceAttributeMultiprocessorCount, dev);
        if (hipFuncSetAttribute((const void*)hybrid_fwd, hipFuncAttributeMaxDynamicSharedMemorySize, LDS_BYTES) != hipSuccess) { fprintf(stderr, "kernel_launch: hipFuncSetAttribute failed\n"); grid = -1; return; }
        if (hipOccupancyMaxActiveBlocksPerMultiprocessor(&per_cu, (const void*)hybrid_fwd, NTHR, LDS_BYTES) != hipSuccess || per_cu < 1) { fprintf(stderr, "kernel_launch: occupancy query gave %d\n", per_cu); per_cu = 1; }
        (void)hipGetLastError();
        grid = cus > 0 ? cus : 256;
    }
    if (grid < 0) return;
    Args a{};
    a.x = (const float*)d_in[0]; a.norm_mix_g = (const float*)d_in[1]; a.w_in = (const float*)d_in[2]; a.fox_b_f = (const float*)d_in[3]; a.pool_w = (const float*)d_in[4];
    a.pool_scale = (const float*)d_in[5]; a.sgu_norm_g = (const float*)d_in[6]; a.sgu_w_s = (const float*)d_in[7]; a.sgu_b = (const float*)d_in[8]; a.ret_norm_g = (const float*)d_in[9];
    a.w_out = (const float*)d_in[10]; a.norm_mlp_g = (const float*)d_in[11]; a.w_ff1 = (const float*)d_in[12]; a.w_ff2 = (const float*)d_in[13]; a.norm_final_g = (const float*)d_in[14];
    a.out = (float*)d_out; a.ws = (unsigned char*)d_ws;
    if (hipMemsetAsync(d_ws, 0, 16384, stream) != hipSuccess) { fprintf(stderr, "kernel_launch: memset of barrier words failed\n"); return; }
    void* args[] = {&a};
    hipError_t e = hipLaunchCooperativeKernel((const void*)hybrid_fwd, dim3(grid), dim3(NTHR), args, LDS_BYTES, stream);
    if (e != hipSuccess) fprintf(stderr, "kernel_launch: cooperative launch failed: %s (grid %d)\n", hipGetErrorString(e), grid);
}
```

```cpp
#include <hip/hip_runtime.h>
#include <hip/hip_cooperative_groups.h>
#include <cstdio>
#include <cstdint>
namespace cg = cooperative_groups;
namespace pg8 {
#define PG8_LAS __attribute__((address_space(3)))
typedef unsigned short bf16_t;
typedef short bf16x8 __attribute__((ext_vector_type(8)));
typedef float f32x4 __attribute__((ext_vector_type(4)));
typedef unsigned u32x4 __attribute__((ext_vector_type(4)));
constexpr int BM = 256, BK = 64, HALF = 128, HTB = HALF * BK * 2  , STAGE_BYTES = 8 * HTB, NXCD = 8, WGM = 8;

__host__ __device__ __forceinline__ int lds_byte(int r, int c) { const int st = (r >> 4) * 2 + (c >> 5), rr = r & 15, cc = c & 31, ob = rr * 64 + cc * 2; return st * 1024 + (ob ^ (((ob >> 9) & 1) << 5)); }
__host__ __device__ __forceinline__ void stage_rc(int b, int& R, int& C) { const int st = b / 1024, sb = b % 1024, swz = sb ^ (((sb >> 9) & 1) << 5); R = (st >> 1) * 16 + swz / 64; C = (st & 1) * 32 + (swz % 64) / 2; }
__host__ __device__ __forceinline__ int perm32(int rho) { const int n = rho >> 4, i = rho & 15; return 8 * (i >> 2) + 4 * n + (i & 3); }

struct Unit { int pm, pn; };
struct Gemm { const bf16_t* A; const bf16_t* Bt; int M, N, K; };

struct StaticOrder {
    int nM, nN, nwg, G, c, wgm;
    __host__ __device__ void init(int M, int N, int G_, int c_, int wgm_ = WGM) { nM = M / BM; nN = N / BM; nwg = nM * nN; G = G_; c = c_; wgm = wgm_; }
    __host__ __device__ bool next(int i, Unit& u) const {
        const long L = (long)i * G + c; if (L >= nwg) return false;
        int wgid = (int)L; { const int q = nwg / NXCD, r = nwg % NXCD, xcd = wgid % NXCD, off = wgid / NXCD; wgid = (xcd < r ? xcd * (q + 1) : r * (q + 1) + (xcd - r) * q) + off; }
        const int nig = wgm * nN, gid = wgid / nig, fm = gid * wgm, gsz = (nM - fm) < wgm ? (nM - fm) : wgm;
        u.pm = fm + ((wgid % nig) % gsz); u.pn = (wgid % nig) / gsz; return true;
    }
    __device__ __forceinline__ void a_ready(const Unit&, int, PG8_LAS unsigned char*) const {}
    __device__ __forceinline__ void done(const Unit&) const {}
};

typedef float f32x2c __attribute__((ext_vector_type(2)));
typedef __bf16 bf16x2c __attribute__((ext_vector_type(2)));
__device__ __forceinline__ unsigned cvt_pk_bf16(float lo, float hi) { const f32x2c v = {lo, hi}; const bf16x2c b = __builtin_convertvector(v, bf16x2c); return __builtin_bit_cast(unsigned, b); }
template <class Epi, class Sched, bool ALIGN_EPI = false, bool SP2 = false>
__device__ __forceinline__ void gemm_phase(PG8_LAS unsigned char* lds, const Gemm g, const Sched& S, const Epi& E) {
    int tid_l = threadIdx.x; asm volatile("" : "+v"(tid_l)); const int tid = tid_l, wid = __builtin_amdgcn_readfirstlane(tid >> 6), lane = tid & 63, wr = wid >> 2, wc = wid & 3, fr = lane & 15, fq = lane >> 4;
    const int K = g.K, nt = K / BK;
    unsigned voffA[2], voffB[2];
#pragma unroll
    for (int i = 0; i < 2; ++i) { int R, C; stage_rc(tid * 16 + i * 8192, R, C); const int Rb = Epi::PERM ? ((R & ~31) + perm32(R & 31)) : R;
        voffA[i] = (unsigned)(R * K + C) * 2u; voffB[i] = (unsigned)(Rb * K + C) * 2u; }
    const size_t kstep = (size_t)(BK * 2);
    const size_t hstep = (size_t)HALF * K * 2;
    const size_t tstep = 2 * hstep;
    const unsigned ldsw = (unsigned)wid * 1024u;
    const int aoff = lds_byte(wr * 64 + fr, fq * 8), boff = lds_byte(wc * 32 + fr, fq * 8);
#define PG8_SA(b, h) (((b) * 2 + (h)) * HTB)
#define PG8_SB(b, h) ((4 + (b) * 2 + (h)) * HTB)
#define PG8_STAGE(bufoff, gbase, voff) do { _Pragma("unroll") for (int _i = 0; _i < 2; ++_i) \
        __builtin_amdgcn_global_load_lds((const unsigned*)((const char*)(gbase) + (voff)[_i]), (PG8_LAS unsigned*)(lds + (bufoff) + ldsw + _i * 8192), 16, 0, 0); } while (0)
#define PG8_LDA(dst, b, h) do { _Pragma("unroll") for (int m = 0; m < 4; ++m) _Pragma("unroll") for (int k = 0; k < 2; ++k) dst[m][k] = *(const PG8_LAS bf16x8*)(lds + PG8_SA(b, h) + aoff + m * 2048 + k * 1024); } while (0)
#define PG8_LDB(dst, b, h) do { _Pragma("unroll") for (int n = 0; n < 2; ++n) _Pragma("unroll") for (int k = 0; k < 2; ++k) dst[n][k] = *(const PG8_LAS bf16x8*)(lds + PG8_SB(b, h) + boff + n * 2048 + k * 1024); } while (0)
#define PG8_MMA(ai, bj, At, Bt) do { __builtin_amdgcn_s_setprio(1); _Pragma("unroll") for (int m = 0; m < 4; ++m) _Pragma("unroll") for (int n = 0; n < 2; ++n) _Pragma("unroll") for (int k = 0; k < 2; ++k) \
        acc[ai][bj][m][n] = __builtin_amdgcn_mfma_f32_16x16x32_bf16(Bt[n][k], At[m][k], acc[ai][bj][m][n], 0, 0, 0); __builtin_amdgcn_s_setprio(0); } while (0)
#define PG8_WAIT_V(n) asm volatile("s_waitcnt vmcnt(" #n ")" ::: "memory")
#define PG8_WAIT_L(n) asm volatile("s_waitcnt lgkmcnt(" #n ")" ::: "memory")
#define PG8_BAR __builtin_amdgcn_s_barrier()
#define PG8_SCHED __builtin_amdgcn_sched_barrier(0)
    Unit cur, nxt; int ui = 0;
    if (!S.next(0, cur)) return;
    f32x4 acc[2][2][4][2];
#pragma unroll
    for (int a = 0; a < 2; ++a)
#pragma unroll
        for (int b = 0; b < 2; ++b)
#pragma unroll
            for (int m = 0; m < 4; ++m)
#pragma unroll
                for (int n = 0; n < 2; ++n) acc[a][b][m][n] = (f32x4){0.f, 0.f, 0.f, 0.f};
    bf16x8 At[4][2], B0[2][2], B1[2][2];
    const char* cA = (const char*)g.A + (size_t)cur.pm * tstep; const char* cB = (const char*)g.Bt + (size_t)cur.pn * tstep;
    S.a_ready(cur, 0, lds);
    if constexpr (SP2) {
        PG8_STAGE(PG8_SB(0, 0), cB, voffB); PG8_STAGE(PG8_SB(0, 1), cB + hstep, voffB); PG8_STAGE(PG8_SA(0, 0), cA, voffA); PG8_STAGE(PG8_SA(0, 1), cA + hstep, voffA);
        if (wr == 1) PG8_BAR;
        PG8_WAIT_V(2); PG8_BAR;
        PG8_STAGE(PG8_SB(1, 0), cB + kstep, voffB); PG8_STAGE(PG8_SA(1, 0), cA + kstep, voffA); PG8_STAGE(PG8_SB(1, 1), cB + hstep + kstep, voffB);
        PG8_WAIT_V(6); PG8_BAR;
    } else {
        PG8_STAGE(PG8_SB(0, 0), cB, voffB); PG8_STAGE(PG8_SA(0, 0), cA, voffA); PG8_STAGE(PG8_SB(0, 1), cB + hstep, voffB); PG8_STAGE(PG8_SA(0, 1), cA + hstep, voffA);
        if (wr == 1) PG8_BAR;
        PG8_WAIT_V(4); PG8_BAR;
        PG8_STAGE(PG8_SB(1, 0), cB + kstep, voffB); PG8_STAGE(PG8_SA(1, 0), cA + kstep, voffA); PG8_STAGE(PG8_SB(1, 1), cB + hstep + kstep, voffB);
        PG8_WAIT_V(6); PG8_BAR;
    }
    for (;;) {
        const bool has_next = S.next(ui + 1, nxt);
        const char* nA = has_next ? (const char*)g.A + (size_t)nxt.pm * tstep : cA; const char* nB = has_next ? (const char*)g.Bt + (size_t)nxt.pn * tstep : cB;
        for (int t = 0; t < nt; t += 2) {
            const bool last = (t == nt - 2);
            const char* a1 = cA + (size_t)(t + 1) * kstep;
            const char* a2 = last ? nA : cA + (size_t)(t + 2) * kstep; const char* b2 = last ? nB : cB + (size_t)(t + 2) * kstep;
            const char* a3 = a2 + kstep; const char* b3 = b2 + kstep;
            if (last && has_next) S.a_ready(nxt, (ui + 1) & 1, lds);
            if constexpr (SP2) {
            PG8_LDB(B0, 0, 0); PG8_LDB(B1, 0, 1); PG8_SCHED; PG8_LDA(At, 0, 0); PG8_STAGE(PG8_SA(1, 1), a1 + hstep, voffA);
            PG8_WAIT_V(8); PG8_WAIT_L(0); PG8_BAR; PG8_MMA(0, 0, At, B0); PG8_MMA(0, 1, At, B1); PG8_BAR; PG8_SCHED;
            PG8_LDA(At, 0, 1); PG8_STAGE(PG8_SB(0, 0), b2, voffB); PG8_STAGE(PG8_SB(0, 1), b2 + hstep, voffB); PG8_STAGE(PG8_SA(0, 0), a2, voffA);
            PG8_WAIT_V(8); PG8_WAIT_L(0); PG8_BAR; PG8_MMA(1, 0, At, B0); PG8_MMA(1, 1, At, B1); PG8_BAR; PG8_SCHED;
            PG8_LDB(B0, 1, 0); PG8_LDB(B1, 1, 1); PG8_SCHED; PG8_LDA(At, 1, 0); PG8_STAGE(PG8_SA(0, 1), a2 + hstep, voffA);
            PG8_WAIT_V(8); PG8_WAIT_L(0); PG8_BAR; PG8_MMA(0, 0, At, B0); PG8_MMA(0, 1, At, B1); PG8_BAR; PG8_SCHED;
            PG8_LDA(At, 1, 1); PG8_STAGE(PG8_SB(1, 0), b3, voffB); PG8_STAGE(PG8_SB(1, 1), b3 + hstep, voffB); PG8_STAGE(PG8_SA(1, 0), a3, voffA);
            PG8_WAIT_V(8); PG8_WAIT_L(0); PG8_BAR; PG8_MMA(1, 0, At, B0); PG8_MMA(1, 1, At, B1); PG8_BAR; PG8_SCHED;
            } else {
            PG8_LDB(B0, 0, 0); PG8_SCHED; PG8_LDA(At, 0, 0); PG8_STAGE(PG8_SA(1, 1), a1 + hstep, voffA);
            PG8_WAIT_L(8); PG8_BAR; PG8_WAIT_L(0); PG8_MMA(0, 0, At, B0); PG8_BAR; PG8_SCHED;
            PG8_LDB(B1, 0, 1); PG8_STAGE(PG8_SB(0, 0), b2, voffB);
            PG8_BAR; PG8_WAIT_L(0); PG8_MMA(0, 1, At, B1); PG8_BAR;
            PG8_LDA(At, 0, 1); PG8_STAGE(PG8_SA(0, 0), a2, voffA);
            PG8_BAR; PG8_WAIT_L(0); PG8_MMA(1, 0, At, B0); PG8_BAR; PG8_SCHED;
            PG8_STAGE(PG8_SB(0, 1), b2 + hstep, voffB);
            PG8_WAIT_V(6); PG8_BAR; PG8_MMA(1, 1, At, B1); PG8_BAR;
            PG8_LDB(B0, 1, 0); PG8_SCHED; PG8_LDA(At, 1, 0); PG8_STAGE(PG8_SA(0, 1), a2 + hstep, voffA);
            PG8_WAIT_L(8); PG8_BAR; PG8_WAIT_L(0); PG8_MMA(0, 0, At, B0); PG8_BAR; PG8_SCHED;
            PG8_LDB(B1, 1, 1); PG8_STAGE(PG8_SB(1, 0), b3, voffB);
            PG8_BAR; PG8_WAIT_L(0); PG8_MMA(0, 1, At, B1); PG8_BAR;
            PG8_LDA(At, 1, 1); PG8_STAGE(PG8_SA(1, 0), a3, voffA);
            PG8_BAR; PG8_WAIT_L(0); PG8_MMA(1, 0, At, B0); PG8_BAR; PG8_SCHED;
            PG8_STAGE(PG8_SB(1, 1), b3 + hstep, voffB);
            PG8_WAIT_V(6); PG8_BAR; PG8_MMA(1, 1, At, B1); PG8_BAR;
            }
        }
        if constexpr (ALIGN_EPI) { if (wr == 0) PG8_BAR; }
        if constexpr (!Epi::AFTER_DRAIN) { E(acc, cur, wr, wc, fr, fq, ui & 1, lds); S.done(cur); }
        if (!has_next) break;
#pragma unroll
        for (int a = 0; a < 2; ++a)
#pragma unroll
            for (int b = 0; b < 2; ++b)
#pragma unroll
                for (int m = 0; m < 4; ++m)
#pragma unroll
                    for (int n = 0; n < 2; ++n) acc[a][b][m][n] = (f32x4){0.f, 0.f, 0.f, 0.f};
        cur = nxt; cA = nA; cB = nB; ++ui;
        if constexpr (ALIGN_EPI) { if (wr == 1) PG8_BAR; }
    }
    PG8_WAIT_V(0);
    if constexpr (!ALIGN_EPI) { if (wr == 0) PG8_BAR; }
    PG8_BAR;
    if constexpr (Epi::AFTER_DRAIN) { E.fused(acc, cur, wr, wc, fr, fq, lds, wid, lane); S.done(cur); }
#undef PG8_SA
#undef PG8_SB
#undef PG8_STAGE
#undef PG8_LDA
#undef PG8_LDB
#undef PG8_MMA
#undef PG8_WAIT_V
#undef PG8_WAIT_L
#undef PG8_BAR
#undef PG8_SCHED
}
}
namespace pg8 {
constexpr int RS_LDS_OFF = 145152;
struct RsOrder : StaticOrder {
    const float* rs;
    __device__ __forceinline__ void a_ready(const Unit& u, int slot, PG8_LAS unsigned char* lds) const {
        const int t = threadIdx.x, w = __builtin_amdgcn_readfirstlane(t >> 6);
        const float* base = rs + (u.pm * BM + w * 64);
        if (w < 4) __builtin_amdgcn_global_load_lds((const unsigned*)base + (t & 63), (PG8_LAS unsigned*)(lds + RS_LDS_OFF + slot * 1024 + w * 256), 4, 0, 0);
    }
};
struct EpiProj {
    static constexpr bool PERM = true, AFTER_DRAIN = false;
    bf16_t* O; const float* rot; const float* bf; float* logf;
    __device__ __forceinline__ void operator()(const f32x4 (&acc)[2][2][4][2], const Unit& u, int wr, int wc, int fr, int fq, int slot, PG8_LAS unsigned char* lds) const {
        const int row0 = u.pm * BM + wr * 64 + fr, col0 = u.pn * BM + wc * 32 + 8 * fq;
        const PG8_LAS float* rsl = (const PG8_LAS float*)(lds + RS_LDS_OFF + slot * 1024) + wr * 64 + fr;
        const bool rotary = (u.pn == 12) || (u.pn == 13); const float ksc = (u.pn == 13) ? 0.125f : 1.0f;
        if (u.pn == 18) {
            if (wc == 0 && fq == 0) { const f32x4 bv = *(const f32x4*)bf;
#pragma unroll
                for (int ai = 0; ai < 2; ++ai)
#pragma unroll
                    for (int m = 0; m < 4; ++m) { const int row = row0 + ai * HALF + m * 16; const f32x4 x = acc[ai][0][m][0] * rsl[ai * HALF + m * 16] + bv; f32x4 o;
#pragma unroll
                        for (int j = 0; j < 4; ++j) o[j] = fminf(x[j], 0.f) - log1pf(expf(-fabsf(x[j])));
                        *(f32x4*)(logf + (size_t)row * 4) = o; } }
            return; }
#pragma unroll
        for (int ai = 0; ai < 2; ++ai)
#pragma unroll
            for (int m = 0; m < 4; ++m) { const int row = row0 + ai * HALF + m * 16; bf16_t* rowp = O + (size_t)row * 4608 + col0; const float rsv = rsl[ai * HALF + m * 16];
#pragma unroll
                for (int bj = 0; bj < 2; ++bj) { f32x4 v0 = acc[ai][bj][m][0] * rsv, v1 = acc[ai][bj][m][1] * rsv;
                    if (rotary) { const int pos = row & 2047, i0 = ((bj * HALF + wc * 32 + 8 * fq) & 63) >> 1;
                        const f32x4 r0 = *(const f32x4*)(rot + (size_t)(pos * 32 + i0) * 2), r1 = *(const f32x4*)(rot + (size_t)(pos * 32 + i0) * 2 + 4);
                        f32x4 a, b;
                        a[0] = (v0[0] * r0[0] - v0[1] * r0[1]) * ksc; a[1] = (v0[0] * r0[1] + v0[1] * r0[0]) * ksc;
                        a[2] = (v0[2] * r0[2] - v0[3] * r0[3]) * ksc; a[3] = (v0[2] * r0[3] + v0[3] * r0[2]) * ksc;
                        b[0] = (v1[0] * r1[0] - v1[1] * r1[1]) * ksc; b[1] = (v1[0] * r1[1] + v1[1] * r1[0]) * ksc;
                        b[2] = (v1[2] * r1[2] - v1[3] * r1[3]) * ksc; b[3] = (v1[2] * r1[3] + v1[3] * r1[2]) * ksc;
                        v0 = a; v1 = b; }
                    u32x4 w; w.x = cvt_pk_bf16(v0[0], v0[1]); w.y = cvt_pk_bf16(v0[2], v0[3]); w.z = cvt_pk_bf16(v1[0], v1[1]); w.w = cvt_pk_bf16(v1[2], v1[3]);
                    *(u32x4*)(rowp + bj * HALF) = w; } }
    }
};
struct EpiRelu2 {
    static constexpr bool PERM = true, AFTER_DRAIN = false;
    bf16_t* O; int ldc;
    __device__ __forceinline__ void operator()(const f32x4 (&acc)[2][2][4][2], const Unit& u, int wr, int wc, int fr, int fq, int slot, PG8_LAS unsigned char* lds) const {
        const int row0 = u.pm * BM + wr * 64 + fr, col0 = u.pn * BM + wc * 32 + 8 * fq;
#pragma unroll
        for (int ai = 0; ai < 2; ++ai)
#pragma unroll
            for (int m = 0; m < 4; ++m) { bf16_t* rowp = O + (size_t)(row0 + ai * HALF + m * 16) * ldc + col0; const float rsv = ((const PG8_LAS float*)(lds + RS_LDS_OFF + slot * 1024))[wr * 64 + fr + ai * HALF + m * 16];
#pragma unroll
                for (int bj = 0; bj < 2; ++bj) { f32x4 v0 = acc[ai][bj][m][0] * rsv, v1 = acc[ai][bj][m][1] * rsv;
#pragma unroll
                    for (int j = 0; j < 4; ++j) { const float a = fmaxf(v0[j], 0.f), b = fmaxf(v1[j], 0.f); v0[j] = a * a; v1[j] = b * b; }
                    u32x4 w; w.x = cvt_pk_bf16(v0[0], v0[1]); w.y = cvt_pk_bf16(v0[2], v0[3]); w.z = cvt_pk_bf16(v1[0], v1[1]); w.w = cvt_pk_bf16(v1[2], v1[3]);
                    *(u32x4*)(rowp + bj * HALF) = w; } }
    }
};
template <bool COPY> struct EpiResid {
    static constexpr bool PERM = true, AFTER_DRAIN = false;
    const float* res; float* out; bf16_t* xn; float* ssp; int ldc;
    __device__ __forceinline__ void operator()(const f32x4 (&acc)[2][2][4][2], const Unit& u, int wr, int wc, int fr, int fq, int slot, PG8_LAS unsigned char* lds) const {
        const int row0 = u.pm * BM + wr * 64 + fr, col0 = u.pn * BM + wc * 32 + 8 * fq;
#pragma unroll
        for (int ai = 0; ai < 2; ++ai)
#pragma unroll
            for (int m = 0; m < 4; ++m) { const int row = row0 + ai * HALF + m * 16; const size_t off = (size_t)row * ldc + col0; float ss = 0.f;
#pragma unroll
                for (int bj = 0; bj < 2; ++bj) {
                    const f32x4 h0 = *(const f32x4*)(res + off + bj * HALF) + acc[ai][bj][m][0], h1 = *(const f32x4*)(res + off + bj * HALF + 4) + acc[ai][bj][m][1];
                    *(f32x4*)(out + off + bj * HALF) = h0; *(f32x4*)(out + off + bj * HALF + 4) = h1;
                    if (COPY) { u32x4 w; w.x = cvt_pk_bf16(h0[0], h0[1]); w.y = cvt_pk_bf16(h0[2], h0[3]); w.z = cvt_pk_bf16(h1[0], h1[1]); w.w = cvt_pk_bf16(h1[2], h1[3]);
                        *(u32x4*)(xn + off + bj * HALF) = w;
                        ss += (h0[0] * h0[0] + h0[1] * h0[1]) + (h0[2] * h0[2] + h0[3] * h0[3]) + (h1[0] * h1[0] + h1[1] * h1[1]) + (h1[2] * h1[2] + h1[3] * h1[3]); } }
                if (COPY) { ss += __shfl_xor(ss, 16); ss += __shfl_xor(ss, 32);
                    if (fq == 0) ssp[(size_t)row * 32 + u.pn * 4 + wc] = ss; }
                if (m & 1) asm volatile("" ::: "memory"); }
    }
};
}
#define DEV __device__ __forceinline__
#ifndef LAS
#define LAS __attribute__((address_space(3)))
#endif
typedef unsigned short bf16_t;
typedef short bf16x8 __attribute__((ext_vector_type(8)));
typedef short s16x4 __attribute__((ext_vector_type(4)));
typedef float f32x4 __attribute__((ext_vector_type(4)));
typedef unsigned u32x4 __attribute__((ext_vector_type(4)));
typedef unsigned u32x2 __attribute__((ext_vector_type(2)));
typedef LAS const char* lds_cptr;
typedef LAS char* lds_ptr;

constexpr int BATCH = 8, SEQ = 2048, DM = 2048, MTOK = BATCH * SEQ, NPROJ = 4608, INC = 5124, FF = 8192, DEPTH = 2;
constexpr size_t MiB = (size_t)1 << 20;
constexpr size_t WS_WIN = 1 * MiB, WS_WOUT = 20 * MiB, WS_WFF1 = 28 * MiB, WS_WFF2 = 60 * MiB, WS_SMALL = 92 * MiB, WS_XN = 98 * MiB,
                 WS_PROJ = 162 * MiB, WS_MIX = 306 * MiB, WS_FFH = 162 * MiB, WS_END = 418 * MiB;
constexpr size_t SM_POOLWT = 0, SM_ROT = 128 * 1024, SM_LOGF = 640 * 1024, SM_RS = 896 * 1024, SM_SSP = 1024 * 1024;
constexpr int NPROJ_G = 4864;
constexpr int LDS_BYTES = 147456;
constexpr int NWAVES = 8, NTHR = 512;
constexpr float LN_EPS = 1e-6f;

typedef float f32x2_t __attribute__((ext_vector_type(2)));
typedef __bf16 bf16x2_t __attribute__((ext_vector_type(2)));
DEV unsigned pk2(float lo, float hi) { const f32x2_t v = {lo, hi}; const bf16x2_t b = __builtin_convertvector(v, bf16x2_t); return __builtin_bit_cast(unsigned, b); }
DEV float bflo(unsigned w) { return __uint_as_float(w << 16); }
DEV float bfhi(unsigned w) { return __uint_as_float(w & 0xffff0000u); }
DEV float ex2(float x) { return __builtin_amdgcn_exp2f(x); }
DEV float gelu_tanh(float x) { const float z2 = 2.3022081986f * (x + 0.044715f * x * x * x); return x * __builtin_amdgcn_rcpf(1.0f + ex2(-z2)); }
DEV float silu(float x) { return x * __builtin_amdgcn_rcpf(1.0f + ex2(-x * 1.4426950408889634f)); }
DEV float wave_sum(float v) {
#pragma unroll
    for (int o = 1; o < 64; o <<= 1) v += __shfl_xor(v, o);
    return v; }
DEV float red16(float v) { v += __shfl_xor(v, 1); v += __shfl_xor(v, 2); v += __shfl_xor(v, 4); v += __shfl_xor(v, 8); return v; }
DEV float redg(float v) { v += __shfl_xor(v, 16); v += __shfl_xor(v, 32); return v; }
DEV bf16x8 ld_row(lds_cptr base, int pitch, int row, int col) { return *(const LAS bf16x8*)(base + row * pitch + col * 2); }
DEV s16x4 ld_tr(lds_cptr p) { return __builtin_bit_cast(s16x4, __builtin_amdgcn_ds_read_tr16_b64_v4i16((LAS s16x4*)p)); }
DEV bf16x8 cat8(s16x4 a, s16x4 b) { return __builtin_shufflevector(a, b, 0, 1, 2, 3, 4, 5, 6, 7); }
DEV bf16x8 pack8(f32x4 a, f32x4 b) { u32x4 w; w.x = pk2(a[0], a[1]); w.y = pk2(a[2], a[3]); w.z = pk2(b[0], b[1]); w.w = pk2(b[2], b[3]); return __builtin_bit_cast(bf16x8, w); }
DEV f32x4 mfma16(bf16x8 a, bf16x8 b, f32x4 c) { return __builtin_amdgcn_mfma_f32_16x16x32_bf16(a, b, c, 0, 0, 0); }
#define FRESH_IDS int tid_l = threadIdx.x; asm volatile("" : "+v"(tid_l)); const int tid = tid_l, lane = tid & 63, wid = __builtin_amdgcn_readfirstlane(tid >> 6); (void)lane; (void)wid
#define LDS_WAIT() asm volatile("s_waitcnt lgkmcnt(0)" ::: "memory")

struct Args {
    const float *x, *norm_mix_g, *w_in, *fox_b_f, *pool_w, *pool_scale, *sgu_norm_g, *sgu_w_s, *sgu_b, *ret_norm_g, *w_out, *norm_mlp_g, *w_ff1, *w_ff2, *norm_final_g;
    float* out; unsigned char* ws;
};

DEV int win_srccol(int n) {
    if (n >= 4608) return (n - 4608 < 4) ? 3072 + (n - 4608) : -1;
    if (n < 3072) return n;
    if (n >= 3584) return n + 4;
    const int r = n - 3072, which = r >> 8, hh = (r >> 6) & 3, j = r & 63, oj = (j & 1) ? (j >> 1) + 32 : (j >> 1);
    return 3076 + which * 256 + hh * 64 + oj;
}
template <int MAP> DEV void transpose_item(const float* W, int ldw, int K, int nblk, bf16_t* WT, LAS float* scr, int item, int lane, const float* gk) {
    const int kb = item / nblk, nb = item - kb * nblk, k0 = 64 * kb, n0 = 32 * nb;
    const int sc = MAP ? win_srccol(n0 + (lane & 31)) : n0 + (lane & 31);
    const float* wp = W + (size_t)(k0 + (lane >> 5)) * ldw + (sc < 0 ? 0 : sc);
    float v[32];
#pragma unroll
    for (int i = 0; i < 32; ++i) v[i] = wp[(size_t)(2 * i) * ldw];
    const int c = lane & 7;
    f32x4 g0 = {1.f, 1.f, 1.f, 1.f}, g1 = {1.f, 1.f, 1.f, 1.f};
    if (gk) { g0 = *(const f32x4*)(gk + k0 + 8 * c); g1 = *(const f32x4*)(gk + k0 + 8 * c + 4); }
#pragma unroll
    for (int i = 0; i < 32; ++i) scr[(2 * i + (lane >> 5)) * 33 + (lane & 31)] = (MAP && sc < 0) ? 0.f : v[i];
    LDS_WAIT();
#pragma unroll
    for (int j = 0; j < 4; ++j) { const int n = (lane >> 3) + 8 * j; const LAS float* s = scr + (8 * c) * 33 + n;
        u32x4 o; o.x = pk2(s[0 * 33] * g0[0], s[1 * 33] * g0[1]); o.y = pk2(s[2 * 33] * g0[2], s[3 * 33] * g0[3]); o.z = pk2(s[4 * 33] * g1[0], s[5 * 33] * g1[1]); o.w = pk2(s[6 * 33] * g1[2], s[7 * 33] * g1[3]);
        *(u32x4*)(WT + (size_t)(n0 + n) * K + k0 + 8 * c) = o; }
    LDS_WAIT();
}
DEV void convert_layer(const Args& a, int layer, lds_ptr lds) {
    FRESH_IDS; const int G = gridDim.x, bid = blockIdx.x, gw = bid * NWAVES + wid, NGW = G * NWAVES, gtid = bid * NTHR + tid, NGT = G * NTHR;
    LAS float* scr = (LAS float*)(lds + wid * 8448);
    bf16_t* WinT = (bf16_t*)(a.ws + WS_WIN); bf16_t* WoutT = (bf16_t*)(a.ws + WS_WOUT); bf16_t* W1T = (bf16_t*)(a.ws + WS_WFF1); bf16_t* W2T = (bf16_t*)(a.ws + WS_WFF2);
    const float* win = a.w_in + (size_t)layer * DM * INC; const float* wout = a.w_out + (size_t)layer * DM * DM;
    const float* w1 = a.w_ff1 + (size_t)layer * DM * FF; const float* w2 = a.w_ff2 + (size_t)layer * FF * DM;
    constexpr int I_IN = (DM / 64) * (NPROJ_G / 32), I_OUT = (DM / 64) * (DM / 32), I_1 = (DM / 64) * (FF / 32), I_2 = (FF / 64) * (DM / 32);
    constexpr int NITEMS = I_IN + I_OUT + I_1 + I_2;
    for (int it = gw; it < NITEMS; it += NGW) {
        int r = it;
        if (r < I_IN) { transpose_item<1>(win, INC, DM, NPROJ_G / 32, WinT, scr, r, lane, a.norm_mix_g + layer * DM); continue; } r -= I_IN;
        if (r < I_OUT) { transpose_item<0>(wout, DM, DM, DM / 32, WoutT, scr, r, lane, nullptr); continue; } r -= I_OUT;
        if (r < I_1) { transpose_item<0>(w1, FF, DM, FF / 32, W1T, scr, r, lane, a.norm_mlp_g + layer * DM); continue; } r -= I_1;
        transpose_item<0>(w2, DM, FF, DM / 32, W2T, scr, r, lane, nullptr);
    }
    bf16_t* pwt = (bf16_t*)(a.ws + WS_SMALL + SM_POOLWT);
    const float* pw = a.pool_w + (size_t)layer * 4 * 128 * 128; const float* ps = a.pool_scale + (size_t)layer * 512;
    for (int e = gtid; e < 4 * 128 * 128; e += NGT) { const int g = e >> 14, d = (e >> 7) & 127, c = e & 127;
        const float v = pw[(g * 128 + c) * 128 + d] * ps[g * 128 + d]; pwt[e] = (bf16_t)(pk2(v, 0.f) & 0xffffu); }
}
DEV void rot_table(const Args& a) {
    FRESH_IDS; const int gtid = blockIdx.x * NTHR + tid, NGT = gridDim.x * NTHR;
    float* rot = (float*)(a.ws + WS_SMALL + SM_ROT);
    for (int e = gtid; e < SEQ * 32; e += NGT) { const int pos = e >> 5, i = e & 31;
        double inv = 1.0; for (int k = 0; k < i; ++k) inv *= 0.74989420933245582730;
        const double ang = (double)pos * inv;
        const double n = rint(ang * 0.63661977236758134308); const double y = ang - n * 1.57079632679489661923; const double y2 = y * y;
        const double sn = y * (1.0 + y2 * (-1.0 / 6 + y2 * (1.0 / 120 + y2 * (-1.0 / 5040 + y2 * (1.0 / 362880 + y2 * (-1.0 / 39916800))))));
        const double cs = 1.0 + y2 * (-0.5 + y2 * (1.0 / 24 + y2 * (-1.0 / 720 + y2 * (1.0 / 40320 + y2 * (-1.0 / 3628800 + y2 * (1.0 / 479001600))))));
        const int qd = ((int)n) & 3; double c, s;
        if (qd == 0) { c = cs; s = sn; } else if (qd == 1) { c = -sn; s = cs; } else if (qd == 2) { c = -cs; s = -sn; } else { c = sn; s = -cs; }
        rot[2 * e] = (float)c; rot[2 * e + 1] = (float)s; }
}

template <int MODE> DEV void norm_phase(const float* src, const float* gvec, bf16_t* xn, float* outf, float* rsout) {
    FRESH_IDS; const int gw = blockIdx.x * NWAVES + wid, NGW = gridDim.x * NWAVES;
    for (int m = gw; m < MTOK; m += NGW) {
        const f32x4* xr = (const f32x4*)(src + (size_t)m * DM) + lane;
        f32x4 v[8]; float s = 0.f;
#pragma unroll
        for (int j = 0; j < 8; ++j) { v[j] = xr[64 * j]; s += (v[j][0] * v[j][0] + v[j][1] * v[j][1]) + (v[j][2] * v[j][2] + v[j][3] * v[j][3]); }
        s = wave_sum(s);
        const float rs = 1.0f / sqrtf(s * (1.0f / DM) + LN_EPS);
        if (MODE == 2) { f32x4* o = (f32x4*)(outf + (size_t)m * DM) + lane;
#pragma unroll
            for (int j = 0; j < 8; ++j) { const f32x4 g = ((const f32x4*)gvec)[lane + 64 * j]; o[64 * j] = v[j] * rs * g; }
        } else { u32x2* o = (u32x2*)(xn + (size_t)m * DM) + lane;
#pragma unroll
            for (int j = 0; j < 8; ++j) { u32x2 w; w.x = pk2(v[j][0], v[j][1]); w.y = pk2(v[j][2], v[j][3]); o[64 * j] = w; }
            if (lane == 0) rsout[m] = rs; }
    }
}
DEV void rs_phase(const float* ssp, float* rsout) {
    FRESH_IDS; const int gtid = blockIdx.x * NTHR + tid, NGT = gridDim.x * NTHR;
    for (int m = gtid; m < MTOK; m += NGT) { const f32x4* p = (const f32x4*)(ssp + (size_t)m * 32); float s = 0.f;
#pragma unroll
        for (int j = 0; j < 8; ++j) { const f32x4 v = p[j]; s += (v[0] + v[1]) + (v[2] + v[3]); }
        rsout[m] = 1.0f / sqrtf(s * (1.0f / DM) + LN_EPS); }
}
#define XB_TMO      128
#define XB_XCNT(j)  (256  + 64 * (j))
#define XB_XSUB(j)  (1280 + 64 * (j))
#define XB_XGEN(j)  (2304 + 64 * (j))
#define XB_TOP      3328
#define XB_TOPGEN   3392
#define XCD_BAR_WORDS 3456
#define XB_SPIN_CAP (1u << 18)

__device__ __forceinline__ unsigned xb_ld(unsigned* p)              { return __hip_atomic_load(p, __ATOMIC_RELAXED, __HIP_MEMORY_SCOPE_AGENT); }
__device__ __forceinline__ unsigned xb_add(unsigned* p, unsigned v) { return __hip_atomic_fetch_add(p, v, __ATOMIC_RELAXED, __HIP_MEMORY_SCOPE_AGENT); }
__device__ __forceinline__ unsigned xb_xcc_id() { return (unsigned)__builtin_amdgcn_s_getreg((3 << 11) | 20) & 0xFu; }
#define XB_SPIN(cond, bar) do { unsigned _sp = 0; while (cond) { __builtin_amdgcn_s_sleep(1); \
    if ((++_sp & 255u) == 0u) { if (xb_ld(&(bar)[XB_TMO])) break; if (_sp > XB_SPIN_CAP) { atomicAdd(&(bar)[XB_TMO], 1u); break; } } } } while (0)

struct XcdBarrier {
    unsigned* bar; unsigned x;
    volatile LAS unsigned* st;
};

__device__ __forceinline__ XcdBarrier xcd_barrier_post(unsigned* bar, volatile LAS unsigned* st) {
    XcdBarrier b; b.bar = bar; b.x = xb_xcc_id(); b.st = st;
    if (threadIdx.x == 0) (void)xb_add(&bar[XB_XCNT(b.x)], 1u);
    return b;
}
__device__ __forceinline__ void xcd_barrier_complete(unsigned* bar, unsigned x, unsigned& nloc, unsigned& nx) {
    const unsigned G = gridDim.x * gridDim.y * gridDim.z;
    unsigned sum, cnt, mine, sp = 0u;
    for (;;) {
        sum = 0u; cnt = 0u; mine = 0u;
#pragma unroll
        for (unsigned j = 0; j < 16; ++j) { const unsigned c = xb_ld(&bar[XB_XCNT(j)]); sum += c; cnt += (c > 0u) ? 1u : 0u; mine = (j == x) ? c : mine; }
        if (sum == G) break;
        __builtin_amdgcn_s_sleep(1);
        if ((++sp & 255u) == 0u) { if (xb_ld(&bar[XB_TMO])) break; if (sp > XB_SPIN_CAP) { atomicAdd(&bar[XB_TMO], 1u); break; } }
    }
    nloc = mine > 0u ? mine : 1u; nx = cnt > 0u ? cnt : 1u;
}

__device__ __forceinline__ void xcd_barrier(const XcdBarrier& b) {
    asm volatile("s_waitcnt vmcnt(0)" ::: "memory");
    __syncthreads();
    if (threadIdx.x == 0) {
        unsigned* bar = b.bar;
        __builtin_amdgcn_s_waitcnt(0);
        unsigned nloc = b.st[0], nx = b.st[1];
        if (nloc == 0u) { xcd_barrier_complete(bar, b.x, nloc, nx); b.st[0] = nloc; b.st[1] = nx; }
        const unsigned old = xb_add(&bar[XB_XSUB(b.x)], 1u);
        const unsigned gen = old / nloc;
        if (old + 1u == (gen + 1u) * nloc) {
            __builtin_amdgcn_fence(__ATOMIC_RELEASE, "agent");
            asm volatile("s_waitcnt vmcnt(0)" ::: "memory");
            const unsigned og = xb_add(&bar[XB_TOP], 1u);
            const unsigned tg = og / nx;
            if (og + 1u == (tg + 1u) * nx) xb_add(&bar[XB_TOPGEN], 1u);
            else XB_SPIN(xb_ld(&bar[XB_TOPGEN]) == tg, bar);
            __builtin_amdgcn_fence(__ATOMIC_ACQUIRE, "agent");
            xb_add(&bar[XB_XGEN(b.x)], 1u);
            asm volatile("s_waitcnt vmcnt(0)" ::: "memory");
        } else {
            XB_SPIN(xb_ld(&bar[XB_XGEN(b.x)]) == gen, bar);
            __builtin_amdgcn_fence(__ATOMIC_ACQUIRE, "agent");
            asm volatile("s_waitcnt vmcnt(0)" ::: "memory");
        }
    }
    __syncthreads();
}
#define LDS_BARRIER() do { asm volatile("s_waitcnt lgkmcnt(0)" ::: "memory"); __builtin_amdgcn_s_barrier(); asm volatile("" ::: "memory"); } while (0)
constexpr int P128 = 272, P64 = 144;
constexpr int PV = 288, PK = 160;

DEV void fox_tile(lds_cptr Kp, lds_cptr Vp, LAS const float* cs, int key0, int tq, float cq2, bool diag, const bf16x8 (&qf)[4], f32x4 (&o)[8], float& mrun, float& lsum, int g, int r16, int q4, int p4) {
    f32x4 sa[4];
    bf16x8 kf[16]; f32x4 ckv[4];
#pragma unroll
    for (int st = 0; st < 4; ++st)
#pragma unroll
        for (int ks = 0; ks < 4; ++ks) kf[st * 4 + ks] = ld_row(Kp, P128, 16 * st + r16, 32 * ks + 8 * g);
#pragma unroll
    for (int st = 0; st < 4; ++st) ckv[st] = *(const LAS f32x4*)(cs + key0 + 16 * st + 4 * g);
    __builtin_amdgcn_sched_barrier(0); __builtin_amdgcn_s_setprio(1);
#pragma unroll
    for (int st = 0; st < 4; ++st) { sa[st] = cq2 - ckv[st];
#pragma unroll
        for (int ks = 0; ks < 4; ++ks) sa[st] = mfma16(kf[st * 4 + ks], qf[ks], sa[st]); }
    __builtin_amdgcn_s_setprio(0);
    float mx = -INFINITY;
#pragma unroll
    for (int st = 0; st < 4; ++st) {
#pragma unroll
        for (int j = 0; j < 4; ++j) { float l = sa[st][j]; if (diag && (key0 + 16 * st + 4 * g + j > tq)) l = -INFINITY; sa[st][j] = l; mx = fmaxf(mx, l); } }
    mx = fmaxf(mx, __shfl_xor(mx, 16)); mx = fmaxf(mx, __shfl_xor(mx, 32));
    if (__builtin_amdgcn_ballot_w64(mx > mrun) != 0ull) {
        const float mnew = fmaxf(mrun, mx); const float alpha = ex2(mrun - mnew); mrun = mnew;
        lsum = lsum * alpha;
#pragma unroll
        for (int dt = 0; dt < 8; ++dt) o[dt] = o[dt] * alpha;
    } else if (__builtin_amdgcn_ballot_w64(mx - mrun > -140.0f) == 0ull) return;
    float rsum = 0.f;
#pragma unroll
    for (int st = 0; st < 4; ++st)
#pragma unroll
        for (int j = 0; j < 4; ++j) { const float p = ex2(sa[st][j] - mrun); sa[st][j] = p; rsum += p; }
    lsum += rsum;
    bf16x8 pf[2]; pf[0] = pack8(sa[0], sa[1]); pf[1] = pack8(sa[2], sa[3]);
#pragma unroll
    for (int h = 0; h < 2; ++h) { s16x4 vf[4][2][2];
#pragma unroll
        for (int d4 = 0; d4 < 4; ++d4)
#pragma unroll
            for (int i = 0; i < 2; ++i) { lds_cptr vp = Vp + (32 * i + 4 * g + q4) * PV + (16 * (4 * h + d4) + 4 * p4) * 2; vf[d4][i][0] = ld_tr(vp); vf[d4][i][1] = ld_tr(vp + 16 * PV); }
        __builtin_amdgcn_sched_barrier(0); __builtin_amdgcn_s_setprio(1);
#pragma unroll
        for (int d4 = 0; d4 < 4; ++d4)
#pragma unroll
            for (int i = 0; i < 2; ++i) o[4 * h + d4] = mfma16(cat8(vf[d4][i][0], vf[d4][i][1]), pf[i], o[4 * h + d4]);
        __builtin_amdgcn_s_setprio(0); }
}
DEV void fox_item(lds_ptr lds, const bf16_t* PROJ, const float* LOGF, bf16_t* MIX, int b, int hd, int qb) {
    FRESH_IDS;
    const int g = lane >> 4, r16 = lane & 15, q4 = r16 >> 2, p4 = r16 & 3;
    const int t0 = qb * 128, nkeys = t0 + 128, ntiles = nkeys >> 6;
    LAS float* cs = (LAS float*)(lds + 71680); LAS float* wtot = (LAS float*)(lds + 79872);
    const int tq = t0 + 16 * wid + r16;
    bf16x8 qf[4];
    { const bf16_t* qp = PROJ + (size_t)(b * SEQ + tq) * NPROJ + 1536 + hd * 128 + 8 * g;
#pragma unroll
      for (int ks = 0; ks < 4; ++ks) { const u32x4 w = *(const u32x4*)(qp + 32 * ks); const float S2 = 0.08838834764831845f * 1.4426950408889634f;
          u32x4 r; r.x = pk2(bflo(w.x) * S2, bfhi(w.x) * S2); r.y = pk2(bflo(w.y) * S2, bfhi(w.y) * S2); r.z = pk2(bflo(w.z) * S2, bfhi(w.z) * S2); r.w = pk2(bflo(w.w) * S2, bfhi(w.w) * S2);
          qf[ks] = __builtin_bit_cast(bf16x8, r); } }
    {
        const int s0 = tid * 4; float x[4];
#pragma unroll
        for (int e = 0; e < 4; ++e) x[e] = (s0 + e < nkeys) ? LOGF[(size_t)(b * SEQ + s0 + e) * 4 + hd] : 0.f;
        x[1] += x[0]; x[2] += x[1]; x[3] += x[2];
        const float tot = x[3]; float inc = tot;
#pragma unroll
        for (int o = 1; o < 64; o <<= 1) { const float y = __shfl_up(inc, o); if (lane >= o) inc += y; }
        if (lane == 63) wtot[wid] = inc;
        __syncthreads();
        float base = inc - tot; for (int w2 = 0; w2 < wid; ++w2) base += wtot[w2];
        const float L2E = 1.4426950408889634f;
        *(LAS f32x4*)(cs + s0) = (f32x4){(x[0] + base) * L2E, (x[1] + base) * L2E, (x[2] + base) * L2E, (x[3] + base) * L2E};
        __syncthreads();
    }
    const float cq2 = cs[tq];
    u32x4 kr0[2], vr0[2], kr1[2], vr1[2];
#define FOX_GLOAD(KR, VR, kt) do { _Pragma("unroll") for (int it = 0; it < 2; ++it) { const int i = tid + NTHR * it, row = i >> 4, ch = i & 15; \
        const bf16_t* rp = PROJ + (size_t)(b * SEQ + (kt) * 64 + row) * NPROJ + hd * 128 + ch * 8; KR[it] = *(const u32x4*)(rp + 2048); VR[it] = *(const u32x4*)(rp + 2560); } } while (0)
#define FOX_LWRITE(KR, VR, buf) do { _Pragma("unroll") for (int it = 0; it < 2; ++it) { const int i = tid + NTHR * it, row = i >> 4, ch = i & 15; \
        *(LAS u32x4*)(lds + (buf) * 17408 + row * P128 + ch * 16) = KR[it]; *(LAS u32x4*)(lds + 34816 + (buf) * 18432 + row * PV + ch * 16) = VR[it]; } } while (0)
    f32x4 o[8];
#pragma unroll
    for (int dt = 0; dt < 8; ++dt) o[dt] = (f32x4){0.f, 0.f, 0.f, 0.f};
    float mrun = -INFINITY, lsum = 0.f;
    FOX_GLOAD(kr0, vr0, ntiles - 1); FOX_GLOAD(kr1, vr1, ntiles - 2); FOX_LWRITE(kr0, vr0, 0); if (2 < ntiles) FOX_GLOAD(kr0, vr0, ntiles - 3);
#define FOX_STEP(s, KRW, VRW) do { \
        LDS_BARRIER(); \
        { const int kt_ = ntiles - 1 - (s); \
          if (kt_ * 64 <= t0 + 16 * wid + 15) fox_tile(lds + ((s) & 1) * 17408, lds + 34816 + ((s) & 1) * 18432, cs, kt_ * 64, tq, cq2, kt_ * 64 + 63 > t0 + 16 * wid, qf, o, mrun, lsum, g, r16, q4, p4); } \
        if ((s) + 1 < ntiles) FOX_LWRITE(KRW, VRW, ((s) + 1) & 1); \
        if ((s) + 3 < ntiles) FOX_GLOAD(KRW, VRW, ntiles - 1 - ((s) + 3)); } while (0)
    for (int kt = 0; kt < ntiles; kt += 2) { FOX_STEP(kt, kr1, vr1); FOX_STEP(kt + 1, kr0, vr0); }
#undef FOX_STEP
#undef FOX_GLOAD
#undef FOX_LWRITE
    lsum = redg(lsum); const float inv = 1.0f / lsum;
    bf16_t* op = MIX + (size_t)(b * SEQ + tq) * DM + 1024 + hd * 128 + 4 * g;
#pragma unroll
    for (int dt = 0; dt < 8; ++dt) { u32x2 w; w.x = pk2(o[dt][0] * inv, o[dt][1] * inv); w.y = pk2(o[dt][2] * inv, o[dt][3] * inv); *(u32x2*)(op + 16 * dt) = w; }
    __syncthreads();
}

DEV void sgu_item(lds_ptr lds, const bf16_t* PROJ, bf16_t* MIX, const float* ng, const float* w_s, const float* b_s, int b, int c, int hd) {
    FRESH_IDS;
    const int g = lane >> 4, r16 = lane & 15, q4 = r16 >> 2, p4 = r16 & 3;
    const size_t R0 = (size_t)b * SEQ + c * 128;
    lds_ptr Vimg = lds, Wimg = lds + 36864;
#pragma unroll
    for (int it = 0; it < 4; ++it) { const int i = tid + NTHR * it, row = i >> 4, ch = i & 15;
        const u32x4 raw = *(const u32x4*)(PROJ + (R0 + row) * NPROJ + 1024 + hd * 128 + ch * 8);
        float x[8]; x[0] = bflo(raw.x); x[1] = bfhi(raw.x); x[2] = bflo(raw.y); x[3] = bfhi(raw.y); x[4] = bflo(raw.z); x[5] = bfhi(raw.z); x[6] = bflo(raw.w); x[7] = bfhi(raw.w);
        float s = 0.f;
#pragma unroll
        for (int e = 0; e < 8; ++e) { x[e] = gelu_tanh(x[e]); s += x[e]; }
        const float mean = red16(s) * (1.0f / 128.0f); float v = 0.f;
#pragma unroll
        for (int e = 0; e < 8; ++e) { x[e] -= mean; v += x[e] * x[e]; }
        const float rstd = 1.0f / sqrtf(red16(v) * (1.0f / 128.0f) + LN_EPS);
        const f32x4 g0 = *(const f32x4*)(ng + hd * 128 + ch * 8), g1 = *(const f32x4*)(ng + hd * 128 + ch * 8 + 4);
        u32x4 w; w.x = pk2(x[0] * rstd * g0[0], x[1] * rstd * g0[1]); w.y = pk2(x[2] * rstd * g0[2], x[3] * rstd * g0[3]);
        w.z = pk2(x[4] * rstd * g1[0], x[5] * rstd * g1[1]); w.w = pk2(x[6] * rstd * g1[2], x[7] * rstd * g1[3]);
        *(LAS u32x4*)(Vimg + row * PV + ch * 16) = w; }
#pragma unroll
    for (int it = 0; it < 4; ++it) { const int i = tid + NTHR * it, t = i >> 4, ch = i & 15;
        const float* wp = w_s + (size_t)(hd * 128 + t) * 128 + ch * 8; const f32x4 a0 = *(const f32x4*)wp, a1 = *(const f32x4*)(wp + 4);
        float x[8] = {a0[0], a0[1], a0[2], a0[3], a1[0], a1[1], a1[2], a1[3]};
#pragma unroll
        for (int e = 0; e < 8; ++e) if (ch * 8 + e > t) x[e] = 0.f;
        u32x4 w; w.x = pk2(x[0], x[1]); w.y = pk2(x[2], x[3]); w.z = pk2(x[4], x[5]); w.w = pk2(x[6], x[7]);
        *(LAS u32x4*)(Wimg + t * P128 + ch * 16) = w; }
    __syncthreads();
    f32x4 acc[8];
#pragma unroll
    for (int dt = 0; dt < 8; ++dt) acc[dt] = (f32x4){0.f, 0.f, 0.f, 0.f};
    const int tl = 16 * wid + r16;
    u32x2 urv[8];
    { const bf16_t* upl = PROJ + (R0 + tl) * NPROJ + 512 + hd * 128 + 4 * g;
#pragma unroll
      for (int dt = 0; dt < 8; ++dt) urv[dt] = *(const u32x2*)(upl + 16 * dt); }
    const float bias = b_s[hd * 128 + tl];
#pragma unroll
    for (int ks = 0; ks < 4; ++ks) if (32 * ks <= 16 * wid + 15) {
        lds_cptr wp = Wimg + tl * P128 + (32 * ks + 4 * g) * 2;
        const bf16x8 bfr = cat8(*(const LAS s16x4*)wp, *(const LAS s16x4*)(wp + 32));
        s16x4 vf[8][2];
#pragma unroll
        for (int dt = 0; dt < 8; ++dt) { lds_cptr vp = Vimg + (32 * ks + 4 * g + q4) * PV + (16 * dt + 4 * p4) * 2; vf[dt][0] = ld_tr(vp); vf[dt][1] = ld_tr(vp + 16 * PV); }
        __builtin_amdgcn_sched_barrier(0); __builtin_amdgcn_s_setprio(1);
#pragma unroll
        for (int dt = 0; dt < 8; ++dt) acc[dt] = mfma16(cat8(vf[dt][0], vf[dt][1]), bfr, acc[dt]);
        __builtin_amdgcn_s_setprio(0); }
    bf16_t* op = MIX + (R0 + tl) * DM + 512 + hd * 128 + 4 * g;
#pragma unroll
    for (int dt = 0; dt < 8; ++dt) { const u32x2 ur = urv[dt];
        const float u0 = gelu_tanh(bflo(ur.x)), u1 = gelu_tanh(bfhi(ur.x)), u2 = gelu_tanh(bflo(ur.y)), u3 = gelu_tanh(bfhi(ur.y));
        u32x2 w; w.x = pk2(u0 * (acc[dt][0] + bias), u1 * (acc[dt][1] + bias)); w.y = pk2(u2 * (acc[dt][2] + bias), u3 * (acc[dt][3] + bias)); *(u32x2*)(op + 16 * dt) = w; }
    __syncthreads();
}

template <int WIN> DEV void pool_stage(lds_ptr Pimg, const bf16_t* PROJ, size_t R0, int c, int gi, int tid) {
#pragma unroll 1
    for (int it = 0; it < 4; ++it) { const int i = tid + NTHR * it, row = i >> 4, ch = i & 15, t = c * 128 + row;
        const bf16_t* rp = PROJ + (R0 + row) * NPROJ + gi * 128 + ch * 8;
        u32x4 raw[WIN];
#pragma unroll
        for (int j = 0; j < WIN; ++j) { raw[j] = (u32x4){0u, 0u, 0u, 0u}; if (t - j >= 0) raw[j] = *(const u32x4*)(rp - (size_t)j * NPROJ); }
        float s[8];
#pragma unroll
        for (int e = 0; e < 8; ++e) s[e] = 0.f;
#pragma unroll
        for (int j = 0; j < WIN; ++j) { s[0] += bflo(raw[j].x); s[1] += bfhi(raw[j].x); s[2] += bflo(raw[j].y); s[3] += bfhi(raw[j].y); s[4] += bflo(raw[j].z); s[5] += bfhi(raw[j].z); s[6] += bflo(raw[j].w); s[7] += bfhi(raw[j].w); }
        const float rc = __builtin_amdgcn_rcpf((float)min(t + 1, WIN));
        u32x4 w; w.x = pk2(s[0] * rc - bflo(raw[0].x), s[1] * rc - bfhi(raw[0].x)); w.y = pk2(s[2] * rc - bflo(raw[0].y), s[3] * rc - bfhi(raw[0].y));
        w.z = pk2(s[4] * rc - bflo(raw[0].z), s[5] * rc - bfhi(raw[0].z)); w.w = pk2(s[6] * rc - bflo(raw[0].w), s[7] * rc - bfhi(raw[0].w));
        *(LAS u32x4*)(Pimg + row * P128 + ch * 16) = w; }
}
DEV void pool_item(lds_ptr lds, const bf16_t* PROJ, bf16_t* MIX, const bf16_t* pwt, int b, int c, int gi) {
    FRESH_IDS;
    const int g = lane >> 4, r16 = lane & 15;
    const size_t R0 = (size_t)b * SEQ + c * 128;
    lds_ptr Pimg = lds, Wimg = lds + 34816;
    switch (gi) { case 0: pool_stage<2>(Pimg, PROJ, R0, c, gi, tid); break; case 1: pool_stage<4>(Pimg, PROJ, R0, c, gi, tid); break;
                  case 2: pool_stage<8>(Pimg, PROJ, R0, c, gi, tid); break; default: pool_stage<16>(Pimg, PROJ, R0, c, gi, tid); break; }
#pragma unroll
    for (int it = 0; it < 4; ++it) { const int i = tid + NTHR * it, row = i >> 4, ch = i & 15;
        *(LAS u32x4*)(Wimg + row * P128 + ch * 16) = *(const u32x4*)(pwt + (size_t)gi * 16384 + row * 128 + ch * 8); }
    __syncthreads();
    f32x4 acc[8];
#pragma unroll
    for (int dt = 0; dt < 8; ++dt) acc[dt] = (f32x4){0.f, 0.f, 0.f, 0.f};
    const int tl = 16 * wid + r16;
#pragma unroll
    for (int ks = 0; ks < 4; ++ks) { const bf16x8 bfr = ld_row(Pimg, P128, tl, 32 * ks + 8 * g); bf16x8 wf[8];
#pragma unroll
        for (int dt = 0; dt < 8; ++dt) wf[dt] = ld_row(Wimg, P128, 16 * dt + r16, 32 * ks + 8 * g);
        __builtin_amdgcn_sched_barrier(0); __builtin_amdgcn_s_setprio(1);
#pragma unroll
        for (int dt = 0; dt < 8; ++dt) acc[dt] = mfma16(wf[dt], bfr, acc[dt]);
        __builtin_amdgcn_s_setprio(0); }
    bf16_t* op = MIX + (R0 + tl) * DM + gi * 128 + 4 * g;
#pragma unroll
    for (int dt = 0; dt < 8; ++dt) { u32x2 w; w.x = pk2(acc[dt][0], acc[dt][1]); w.y = pk2(acc[dt][2], acc[dt][3]); *(u32x2*)(op + 16 * dt) = w; }
    __syncthreads();
}

DEV void ret_item(lds_ptr lds, const bf16_t* PROJ, bf16_t* MIX, const float* ng, int b, int hd, int c) {
    FRESH_IDS;
    const int g = lane >> 4, r16 = lane & 15, q4 = r16 >> 2, p4 = r16 & 3;
    const float lg2 = __log2f(1.0f - ex2(-5.0f - (float)hd));
    const size_t R0 = (size_t)b * SEQ + c * 128;
    const int l = 16 * wid + r16;
    bf16x8 qf[2];
    { const bf16_t* qp = PROJ + (R0 + l) * NPROJ + 3072 + hd * 64 + 8 * g; qf[0] = *(const bf16x8*)qp; qf[1] = *(const bf16x8*)(qp + 32); }
    lds_ptr Rt = lds + 114688;
    u32x4 kr0[2], vr0[4], kr1[2], vr1[4];
#define RET_GLOAD(KR, VR, j) do { const size_t rb = (size_t)b * SEQ + (j) * 128; \
        _Pragma("unroll") for (int it = 0; it < 2; ++it) { const int i = tid + NTHR * it, row = i >> 3, ch = i & 7; KR[it] = *(const u32x4*)(PROJ + (rb + row) * NPROJ + 3328 + hd * 64 + ch * 8); } \
        _Pragma("unroll") for (int it = 0; it < 4; ++it) { const int i = tid + NTHR * it, row = i >> 4, ch = i & 15; VR[it] = *(const u32x4*)(PROJ + (rb + row) * NPROJ + 3584 + hd * 128 + ch * 8); } } while (0)
#define RET_LWRITE(KR, VR, j, buf) do { \
        _Pragma("unroll") for (int it = 0; it < 2; ++it) { const int i = tid + NTHR * it, row = i >> 3, ch = i & 7; u32x4 w = KR[it]; \
            if ((j) < c) { const float f = ex2(lg2 * (float)((c - (j)) * 128 - 1 - row)); \
                w.x = pk2(bflo(w.x) * f, bfhi(w.x) * f); w.y = pk2(bflo(w.y) * f, bfhi(w.y) * f); w.z = pk2(bflo(w.z) * f, bfhi(w.z) * f); w.w = pk2(bflo(w.w) * f, bfhi(w.w) * f); } \
            *(LAS u32x4*)(lds + (buf) * 20480 + row * PK + ch * 16) = w; } \
        _Pragma("unroll") for (int it = 0; it < 4; ++it) { const int i = tid + NTHR * it, row = i >> 4, ch = i & 15; *(LAS u32x4*)(lds + 40960 + (buf) * 36864 + row * PV + ch * 16) = VR[it]; } } while (0)
    const int dtl = wid & 3, eb = (wid >> 2) * 4;
    f32x4 sacc[4];
#pragma unroll
    for (int et = 0; et < 4; ++et) sacc[et] = (f32x4){0.f, 0.f, 0.f, 0.f};
    RET_GLOAD(kr0, vr0, 0); if (c >= 1) RET_GLOAD(kr1, vr1, 1); RET_LWRITE(kr0, vr0, 0, 0); if (c >= 2) RET_GLOAD(kr0, vr0, 2);
#define RET_STEP(j, KRW, VRW) do { \
        LDS_BARRIER(); \
        { lds_cptr Kp = lds + ((j) & 1) * 20480; lds_cptr Vp = lds + 40960 + ((j) & 1) * 36864; \
          _Pragma("unroll") for (int k2 = 0; k2 < 2; ++k2) { s16x4 af[2][2], vf[2][4][2]; \
            _Pragma("unroll") for (int kk = 0; kk < 2; ++kk) { const int ks = 2 * k2 + kk; lds_cptr kp = Kp + (32 * ks + 4 * g + q4) * PK + (16 * dtl + 4 * p4) * 2; af[kk][0] = ld_tr(kp); af[kk][1] = ld_tr(kp + 16 * PK); \
                _Pragma("unroll") for (int et = 0; et < 4; ++et) { lds_cptr vp = Vp + (32 * ks + 4 * g + q4) * PV + (16 * (eb + et) + 4 * p4) * 2; vf[kk][et][0] = ld_tr(vp); vf[kk][et][1] = ld_tr(vp + 16 * PV); } } \
            __builtin_amdgcn_sched_barrier(0); __builtin_amdgcn_s_setprio(1); \
            _Pragma("unroll") for (int kk = 0; kk < 2; ++kk) _Pragma("unroll") for (int et = 0; et < 4; ++et) sacc[et] = mfma16(cat8(af[kk][0], af[kk][1]), cat8(vf[kk][et][0], vf[kk][et][1]), sacc[et]); __builtin_amdgcn_s_setprio(0); } } \
        RET_LWRITE(KRW, VRW, (j) + 1, ((j) + 1) & 1); \
        if ((j) + 3 <= c) RET_GLOAD(KRW, VRW, (j) + 3); } while (0)
    for (int j = 0; j < c; j += 2) { RET_STEP(j, kr1, vr1); if (j + 1 < c) RET_STEP(j + 1, kr0, vr0); }
#undef RET_STEP
#undef RET_GLOAD
#undef RET_LWRITE
#pragma unroll
    for (int et = 0; et < 4; ++et) { u32x2 w; w.x = pk2(sacc[et][0], sacc[et][1]); w.y = pk2(sacc[et][2], sacc[et][3]);
        *(LAS u32x2*)(Rt + (16 * (eb + et) + r16) * P64 + (16 * dtl + 4 * g) * 2) = w; }
    __syncthreads();
    f32x4 y[8];
#pragma unroll
    for (int et = 0; et < 8; ++et) y[et] = (f32x4){0.f, 0.f, 0.f, 0.f};
    if (c > 0) {
        bf16x8 rf[16];
#pragma unroll
        for (int et = 0; et < 8; ++et)
#pragma unroll
            for (int ks = 0; ks < 2; ++ks) rf[et * 2 + ks] = ld_row(Rt, P64, 16 * et + r16, 32 * ks + 8 * g);
        __builtin_amdgcn_sched_barrier(0); __builtin_amdgcn_s_setprio(1);
#pragma unroll
        for (int et = 0; et < 8; ++et)
#pragma unroll
            for (int ks = 0; ks < 2; ++ks) y[et] = mfma16(rf[et * 2 + ks], qf[ks], y[et]);
        __builtin_amdgcn_s_setprio(0);
        const float xi = ex2(lg2 * (float)(l + 1));
#pragma unroll
        for (int et = 0; et < 8; ++et) y[et] = y[et] * xi;
    }
    lds_cptr Kp = lds + (c & 1) * 20480; lds_cptr Vp = lds + 40960 + (c & 1) * 36864;
    u32x2 grv[8]; f32x4 gnv[8];
    { const bf16_t* gpl = PROJ + (R0 + l) * NPROJ + 4096 + hd * 128 + 4 * g;
#pragma unroll
      for (int et = 0; et < 8; ++et) { grv[et] = *(const u32x2*)(gpl + 16 * et); gnv[et] = *(const f32x4*)(ng + hd * 128 + 16 * et + 4 * g); } }
    for (int i = 0; i <= (wid >> 1); ++i) {
        f32x4 pa[2];
#pragma unroll
        for (int h2 = 0; h2 < 2; ++h2) { const int mt = 2 * i + h2; pa[h2] = (f32x4){0.f, 0.f, 0.f, 0.f};
            if (mt <= wid) {
#pragma unroll
                for (int ks = 0; ks < 2; ++ks) pa[h2] = mfma16(ld_row(Kp, PK, 16 * mt + r16, 32 * ks + 8 * g), qf[ks], pa[h2]);
#pragma unroll
                for (int r = 0; r < 4; ++r) { const int dl = l - (16 * mt + 4 * g + r); pa[h2][r] = (dl >= 0) ? pa[h2][r] * ex2(lg2 * (float)dl) : 0.f; } } }
        const bf16x8 pf = pack8(pa[0], pa[1]);
        s16x4 vf[8][2];
#pragma unroll
        for (int et = 0; et < 8; ++et) { lds_cptr vp = Vp + (32 * i + 4 * g + q4) * PV + (16 * et + 4 * p4) * 2; vf[et][0] = ld_tr(vp); vf[et][1] = ld_tr(vp + 16 * PV); }
        __builtin_amdgcn_sched_barrier(0); __builtin_amdgcn_s_setprio(1);
#pragma unroll
        for (int et = 0; et < 8; ++et) y[et] = mfma16(cat8(vf[et][0], vf[et][1]), pf, y[et]);
        __builtin_amdgcn_s_setprio(0);
    }
    float s = 0.f;
#pragma unroll
    for (int et = 0; et < 8; ++et) s += (y[et][0] + y[et][1]) + (y[et][2] + y[et][3]);
    const float mu = redg(s) * (1.0f / 128.0f); float v = 0.f;
#pragma unroll
    for (int et = 0; et < 8; ++et) { y[et] = y[et] - mu; v += (y[et][0] * y[et][0] + y[et][1] * y[et][1]) + (y[et][2] * y[et][2] + y[et][3] * y[et][3]); }
    const float rstd = 1.0f / sqrtf(redg(v) * (1.0f / 128.0f) + LN_EPS);
    bf16_t* op = MIX + (R0 + l) * DM + 1536 + hd * 128 + 4 * g;
#pragma unroll
    for (int et = 0; et < 8; ++et) { const u32x2 gr = grv[et]; const f32x4 gn = gnv[et];
        u32x2 w; w.x = pk2(silu(bflo(gr.x)) * (y[et][0] * rstd * gn[0]), silu(bfhi(gr.x)) * (y[et][1] * rstd * gn[1]));
        w.y = pk2(silu(bflo(gr.y)) * (y[et][2] * rstd * gn[2]), silu(bfhi(gr.y)) * (y[et][3] * rstd * gn[3])); *(u32x2*)(op + 16 * et) = w; }
    __syncthreads();
}
#ifndef PH
#define PH 0xFFFF
#endif
__global__ void __launch_bounds__(NTHR, 2) hybrid_fwd(Args a) {
    extern __shared__ __attribute__((aligned(16))) unsigned char lds_raw[];
    cg::grid_group grid = cg::this_grid();
    lds_ptr lds = (lds_ptr)lds_raw;
    const int G = gridDim.x, bid = blockIdx.x;
    bf16_t* WinT = (bf16_t*)(a.ws + WS_WIN); bf16_t* WoutT = (bf16_t*)(a.ws + WS_WOUT); bf16_t* W1T = (bf16_t*)(a.ws + WS_WFF1); bf16_t* W2T = (bf16_t*)(a.ws + WS_WFF2);
    bf16_t* XN = (bf16_t*)(a.ws + WS_XN); bf16_t* PROJ = (bf16_t*)(a.ws + WS_PROJ); bf16_t* MIX = (bf16_t*)(a.ws + WS_MIX); bf16_t* FFH = (bf16_t*)(a.ws + WS_FFH);
    const bf16_t* PWT = (const bf16_t*)(a.ws + WS_SMALL + SM_POOLWT); const float* ROT = (const float*)(a.ws + WS_SMALL + SM_ROT); float* LOGF = (float*)(a.ws + WS_SMALL + SM_LOGF);
    float* RS = (float*)(a.ws + WS_SMALL + SM_RS); float* SSP = (float*)(a.ws + WS_SMALL + SM_SSP);
    volatile LAS unsigned* MISC = (volatile LAS unsigned*)(lds + 147200);
    unsigned* bar = (unsigned*)a.ws;
    { const int t0_ = threadIdx.x; if (t0_ < 16) MISC[t0_] = 0u; __syncthreads(); }
    if (a.ws == nullptr) grid.sync();
    const XcdBarrier xb = xcd_barrier_post(bar, MISC + 8);

#if PH & 1
    convert_layer(a, 0, lds);
    rot_table(a);
    norm_phase<0>(a.x, nullptr, XN, nullptr, RS);
#endif
    xcd_barrier(xb);

#pragma unroll 1
    for (int layer = 0; layer < DEPTH; ++layer) {
#if PH & 2
        { pg8::Gemm gm{XN, WinT, MTOK, NPROJ_G, DM}; pg8::RsOrder S; S.init(MTOK, NPROJ_G, G, bid); S.rs = RS;
          pg8::EpiProj E{PROJ, ROT, a.fox_b_f + layer * 4, LOGF};
          pg8::gemm_phase<pg8::EpiProj, pg8::RsOrder, true, true>((PG8_LAS unsigned char*)lds, gm, S, E); }
#endif
        xcd_barrier(xb);
#if PH & 4
        {
            const float* sg = a.sgu_norm_g + layer * 512; const float* sw = a.sgu_w_s + (size_t)layer * 4 * 128 * 128; const float* sb = a.sgu_b + layer * 512; const float* rg = a.ret_norm_g + layer * 512;
#pragma unroll 1
            for (int it0 = bid; it0 < 256; it0 += G) { const int it = (G == 256) ? (((it0 & 7) << 5) | (it0 >> 3)) : it0;
                const int b = it >> 5, hd = (it >> 3) & 3, x = it & 7;
#pragma unroll 1
                for (int rep = 0; rep < 2; ++rep) fox_item(lds, PROJ, LOGF, MIX, b, hd, rep ? x : 15 - x);
#pragma unroll 1
                for (int rep = 0; rep < 2; ++rep) ret_item(lds, PROJ, MIX, rg, b, hd, rep ? x : 15 - x); }
#pragma unroll 1
            for (int it0 = bid; it0 < 512; it0 += G) { int b, c, hd, half;
                if (G == 256) { const int idx = ((it0 & 255) >> 3) + 32 * (it0 >> 8); b = it0 & 7; c = idx >> 2; hd = idx & 3; half = it0 >> 8; }
                else { b = it0 >> 6; c = (it0 >> 2) & 15; hd = it0 & 3; half = (it0 >> 8) & 1; }
                sgu_item(lds, PROJ, MIX, sg, sw, sb, b, c, hd);
                pool_item(lds, PROJ, MIX, PWT, b, c, half ? 3 - hd : hd); }
        }
#endif
        xcd_barrier(xb);
#if PH & 8
        { pg8::Gemm gm{MIX, WoutT, MTOK, DM, DM}; pg8::StaticOrder S; S.init(MTOK, DM, G, bid);
          pg8::EpiResid<true> E{layer == 0 ? a.x : a.out, a.out, XN, SSP, DM};
          pg8::gemm_phase<pg8::EpiResid<true>, pg8::StaticOrder, true, true>((PG8_LAS unsigned char*)lds, gm, S, E); }
#endif
        xcd_barrier(xb);
        rs_phase(SSP, RS);
        xcd_barrier(xb);
#if PH & 16
        { pg8::Gemm gm{XN, W1T, MTOK, FF, DM}; pg8::RsOrder S; S.init(MTOK, FF, G, bid); S.rs = RS;
          pg8::EpiRelu2 E{FFH, FF};
          pg8::gemm_phase<pg8::EpiRelu2, pg8::RsOrder, true, true>((PG8_LAS unsigned char*)lds, gm, S, E); }
#endif
        xcd_barrier(xb);
#if PH & 32
        { pg8::Gemm gm{FFH, W2T, MTOK, DM, FF}; pg8::StaticOrder S; S.init(MTOK, DM, G, bid);
          if (layer + 1 < DEPTH) { pg8::EpiResid<true> E{a.out, a.out, XN, SSP, DM};
            pg8::gemm_phase<pg8::EpiResid<true>, pg8::StaticOrder, true, true>((PG8_LAS unsigned char*)lds, gm, S, E); }
          else { pg8::EpiResid<false> E{a.out, a.out, XN, SSP, DM};
            pg8::gemm_phase<pg8::EpiResid<false>, pg8::StaticOrder, true, true>((PG8_LAS unsigned char*)lds, gm, S, E); } }
#endif
        xcd_barrier(xb);
        if (layer + 1 < DEPTH) {
            convert_layer(a, layer + 1, lds);
            rs_phase(SSP, RS);
            xcd_barrier(xb);
        } else {
            norm_phase<2>(a.out, a.norm_final_g, nullptr, a.out, nullptr);
        }
    }
}

extern "C" void kernel_launch(void* const* d_in, const int* in_sizes, int n_in, void* d_out, int out_size, void* d_ws, size_t ws_size, hipStream_t stream) {
    static int grid = 0;
    if (grid == 0) {
        if (n_in != 15 || out_size != MTOK * DM || ws_size < WS_END) { fprintf(stderr, "kernel_launch: unexpected problem (n_in %d, out %d, ws %zu)\n", n_in, out_size, ws_size); grid = -1; return; }
        int dev = 0, cus = 0, per_cu = 0;
        (void)hipGetDevice(&dev); (void)hipDeviceGetAttribute(&cus, hipDeviceAttributeMultiprocessorCount, dev);
        if (hipFuncSetAttribute((const void*)hybrid_fwd, hipFuncAttributeMaxDynamicSharedMemorySize, LDS_BYTES) != hipSuccess) { fprintf(stderr, "kernel_launch: hipFuncSetAttribute failed\n"); grid = -1; return; }
        if (hipOccupancyMaxActiveBlocksPerMultiprocessor(&per_cu, (const void*)hybrid_fwd, NTHR, LDS_BYTES) != hipSuccess || per_cu < 1) { fprintf(stderr, "kernel_launch: occupancy query gave %d\n", per_cu); per_cu = 1; }
        (void)hipGetLastError();
        grid = cus > 0 ? cus : 256;
    }
    if (grid < 0) return;
    Args a{};
    a.x = (const float*)d_in[0]; a.norm_mix_g = (const float*)d_in[1]; a.w_in = (const float*)d_in[2]; a.fox_b_f = (const float*)d_in[3]; a.pool_w = (const float*)d_in[4];
    a.pool_scale = (const float*)d_in[5]; a.sgu_norm_g = (const float*)d_in[6]; a.sgu_w_s = (const float*)d_in[7]; a.sgu_b = (const float*)d_in[8]; a.ret_norm_g = (const float*)d_in[9];
    a.w_out = (const float*)d_in[10]; a.norm_mlp_g = (const float*)d_in[11]; a.w_ff1 = (const float*)d_in[12]; a.w_ff2 = (const float*)d_in[13]; a.norm_final_g = (const float*)d_in[14];
    a.out = (float*)d_out; a.ws = (unsigned char*)d_ws;
    if (hipMemsetAsync(d_ws, 0, 16384, stream) != hipSuccess) { fprintf(stderr, "kernel_launch: memset of barrier words failed\n"); return; }
    void* args[] = {&a};
    hipError_t e = hipLaunchCooperativeKernel((const void*)hybrid_fwd, dim3(grid), dim3(NTHR), args, LDS_BYTES, stream);
    if (e != hipSuccess) fprintf(stderr, "kernel_launch: cooperative launch failed: %s (grid %d)\n", hipGetErrorString(e), grid);
}
```

```cpp
#include <hip/hip_runtime.h>
#include <hip/hip_cooperative_groups.h>
#include <cstdio>
#include <cstdint>
namespace cg = cooperative_groups;
namespace pg8 {
#define PG8_LAS __attribute__((address_space(3)))
typedef unsigned short bf16_t;
typedef short bf16x8 __attribute__((ext_vector_type(8)));
typedef float f32x4 __attribute__((ext_vector_type(4)));
typedef unsigned u32x4 __attribute__((ext_vector_type(4)));
constexpr int BM = 256, BK = 64, HALF = 128, HTB = HALF * BK * 2  , STAGE_BYTES = 8 * HTB, NXCD = 8, WGM = 8;

__host__ __device__ __forceinline__ int lds_byte(int r, int c) { const int st = (r >> 4) * 2 + (c >> 5), rr = r & 15, cc = c & 31, ob = rr * 64 + cc * 2; return st * 1024 + (ob ^ (((ob >> 9) & 1) << 5)); }
__host__ __device__ __forceinline__ void stage_rc(int b, int& R, int& C) { const int st = b / 1024, sb = b % 1024, swz = sb ^ (((sb >> 9) & 1) << 5); R = (st >> 1) * 16 + swz / 64; C = (st & 1) * 32 + (swz % 64) / 2; }
__host__ __device__ __forceinline__ int perm32(int rho) { const int n = rho >> 4, i = rho & 15; return 8 * (i >> 2) + 4 * n + (i & 3); }

struct Unit { int pm, pn; };
struct Gemm { const bf16_t* A; const bf16_t* Bt; int M, N, K; };

struct StaticOrder {
    int nM, nN, nwg, G, c, wgm;
    __host__ __device__ void init(int M, int N, int G_, int c_, int wgm_ = WGM) { nM = M / BM; nN = N / BM; nwg = nM * nN; G = G_; c = c_; wgm = wgm_; }
    __host__ __device__ bool next(int i, Unit& u) const {
        const long L = (long)i * G + c; if (L >= nwg) return false;
        int wgid = (int)L; { const int q = nwg / NXCD, r = nwg % NXCD, xcd = wgid % NXCD, off = wgid / NXCD; wgid = (xcd < r ? xcd * (q + 1) : r * (q + 1) + (xcd - r) * q) + off; }
        const int nig = wgm * nN, gid = wgid / nig, fm = gid * wgm, gsz = (nM - fm) < wgm ? (nM - fm) : wgm;
        u.pm = fm + ((wgid % nig) % gsz); u.pn = (wgid % nig) / gsz; return true;
    }
    __device__ __forceinline__ void a_ready(const Unit&, int, PG8_LAS unsigned char*) const {}
    __device__ __forceinline__ void done(const Unit&) const {}
};

typedef float f32x2c __attribute__((ext_vector_type(2)));
typedef __bf16 bf16x2c __attribute__((ext_vector_type(2)));
__device__ __forceinline__ unsigned cvt_pk_bf16(float lo, float hi) { const f32x2c v = {lo, hi}; const bf16x2c b = __builtin_convertvector(v, bf16x2c); return __builtin_bit_cast(unsigned, b); }
template <class Epi, class Sched, bool ALIGN_EPI = false, bool SP2 = false>
__device__ __forceinline__ void gemm_phase(PG8_LAS unsigned char* lds, const Gemm g, const Sched& S, const Epi& E) {
    int tid_l = threadIdx.x; asm volatile("" : "+v"(tid_l)); const int tid = tid_l, wid = __builtin_amdgcn_readfirstlane(tid >> 6), lane = tid & 63, wr = wid >> 2, wc = wid & 3, fr = lane & 15, fq = lane >> 4;
    const int K = g.K, nt = K / BK;
    unsigned voffA[2], voffB[2];
#pragma unroll
    for (int i = 0; i < 2; ++i) { int R, C; stage_rc(tid * 16 + i * 8192, R, C); const int Rb = Epi::PERM ? ((R & ~31) + perm32(R & 31)) : R;
        voffA[i] = (unsigned)(R * K + C) * 2u; voffB[i] = (unsigned)(Rb * K + C) * 2u; }
    const size_t kstep = (size_t)(BK * 2);
    const size_t hstep = (size_t)HALF * K * 2;
    const size_t tstep = 2 * hstep;
    const unsigned ldsw = (unsigned)wid * 1024u;
    const int aoff = lds_byte(wr * 64 + fr, fq * 8), boff = lds_byte(wc * 32 + fr, fq * 8);
#define PG8_SA(b, h) (((b) * 2 + (h)) * HTB)
#define PG8_SB(b, h) ((4 + (b) * 2 + (h)) * HTB)
#define PG8_STAGE(bufoff, gbase, voff) do { _Pragma("unroll") for (int _i = 0; _i < 2; ++_i) \
        __builtin_amdgcn_global_load_lds((const unsigned*)((const char*)(gbase) + (voff)[_i]), (PG8_LAS unsigned*)(lds + (bufoff) + ldsw + _i * 8192), 16, 0, 0); } while (0)
#define PG8_LDA(dst, b, h) do { _Pragma("unroll") for (int m = 0; m < 4; ++m) _Pragma("unroll") for (int k = 0; k < 2; ++k) dst[m][k] = *(const PG8_LAS bf16x8*)(lds + PG8_SA(b, h) + aoff + m * 2048 + k * 1024); } while (0)
#define PG8_LDB(dst, b, h) do { _Pragma("unroll") for (int n = 0; n < 2; ++n) _Pragma("unroll") for (int k = 0; k < 2; ++k) dst[n][k] = *(const PG8_LAS bf16x8*)(lds + PG8_SB(b, h) + boff + n * 2048 + k * 1024); } while (0)
#define PG8_MMA(ai, bj, At, Bt) do { __builtin_amdgcn_s_setprio(1); _Pragma("unroll") for (int m = 0; m < 4; ++m) _Pragma("unroll") for (int n = 0; n < 2; ++n) _Pragma("unroll") for (int k = 0; k < 2; ++k) \
        acc[ai][bj][m][n] = __builtin_amdgcn_mfma_f32_16x16x32_bf16(Bt[n][k], At[m][k], acc[ai][bj][m][n], 0, 0, 0); __builtin_amdgcn_s_setprio(0); } while (0)
#define PG8_WAIT_V(n) asm volatile("s_waitcnt vmcnt(" #n ")" ::: "memory")
#define PG8_WAIT_L(n) asm volatile("s_waitcnt lgkmcnt(" #n ")" ::: "memory")
#define PG8_BAR __builtin_amdgcn_s_barrier()
#define PG8_SCHED __builtin_amdgcn_sched_barrier(0)
    Unit cur, nxt; int ui = 0;
    if (!S.next(0, cur)) return;
    f32x4 acc[2][2][4][2];
#pragma unroll
    for (int a = 0; a < 2; ++a)
#pragma unroll
        for (int b = 0; b < 2; ++b)
#pragma unroll
            for (int m = 0; m < 4; ++m)
#pragma unroll
                for (int n = 0; n < 2; ++n) acc[a][b][m][n] = (f32x4){0.f, 0.f, 0.f, 0.f};
    bf16x8 At[4][2], B0[2][2], B1[2][2];
    const char* cA = (const char*)g.A + (size_t)cur.pm * tstep; const char* cB = (const char*)g.Bt + (size_t)cur.pn * tstep;
    S.a_ready(cur, 0, lds);
    if constexpr (SP2) {
        PG8_STAGE(PG8_SB(0, 0), cB, voffB); PG8_STAGE(PG8_SB(0, 1), cB + hstep, voffB); PG8_STAGE(PG8_SA(0, 0), cA, voffA); PG8_STAGE(PG8_SA(0, 1), cA + hstep, voffA);
        if (wr == 1) PG8_BAR;
        PG8_WAIT_V(2); PG8_BAR;
        PG8_STAGE(PG8_SB(1, 0), cB + kstep, voffB); PG8_STAGE(PG8_SA(1, 0), cA + kstep, voffA); PG8_STAGE(PG8_SB(1, 1), cB + hstep + kstep, voffB);
        PG8_WAIT_V(6); PG8_BAR;
    } else {
        PG8_STAGE(PG8_SB(0, 0), cB, voffB); PG8_STAGE(PG8_SA(0, 0), cA, voffA); PG8_STAGE(PG8_SB(0, 1), cB + hstep, voffB); PG8_STAGE(PG8_SA(0, 1), cA + hstep, voffA);
        if (wr == 1) PG8_BAR;
        PG8_WAIT_V(4); PG8_BAR;
        PG8_STAGE(PG8_SB(1, 0), cB + kstep, voffB); PG8_STAGE(PG8_SA(1, 0), cA + kstep, voffA); PG8_STAGE(PG8_SB(1, 1), cB + hstep + kstep, voffB);
        PG8_WAIT_V(6); PG8_BAR;
    }
    for (;;) {
        const bool has_next = S.next(ui + 1, nxt);
        const char* nA = has_next ? (const char*)g.A + (size_t)nxt.pm * tstep : cA; const char* nB = has_next ? (const char*)g.Bt + (size_t)nxt.pn * tstep : cB;
        for (int t = 0; t < nt; t += 2) {
            const bool last = (t == nt - 2);
            const char* a1 = cA + (size_t)(t + 1) * kstep;
            const char* a2 = last ? nA : cA + (size_t)(t + 2) * kstep; const char* b2 = last ? nB : cB + (size_t)(t + 2) * kstep;
            const char* a3 = a2 + kstep; const char* b3 = b2 + kstep;
            if (last && has_next) S.a_ready(nxt, (ui + 1) & 1, lds);
            if constexpr (SP2) {
            PG8_LDB(B0, 0, 0); PG8_LDB(B1, 0, 1); PG8_SCHED; PG8_LDA(At, 0, 0); PG8_STAGE(PG8_SA(1, 1), a1 + hstep, voffA);
            PG8_WAIT_V(8); PG8_WAIT_L(0); PG8_BAR; PG8_MMA(0, 0, At, B0); PG8_MMA(0, 1, At, B1); PG8_BAR; PG8_SCHED;
            PG8_LDA(At, 0, 1); PG8_STAGE(PG8_SB(0, 0), b2, voffB); PG8_STAGE(PG8_SB(0, 1), b2 + hstep, voffB); PG8_STAGE(PG8_SA(0, 0), a2, voffA);
            PG8_WAIT_V(8); PG8_WAIT_L(0); PG8_BAR; PG8_MMA(1, 0, At, B0); PG8_MMA(1, 1, At, B1); PG8_BAR; PG8_SCHED;
            PG8_LDB(B0, 1, 0); PG8_LDB(B1, 1, 1); PG8_SCHED; PG8_LDA(At, 1, 0); PG8_STAGE(PG8_SA(0, 1), a2 + hstep, voffA);
            PG8_WAIT_V(8); PG8_WAIT_L(0); PG8_BAR; PG8_MMA(0, 0, At, B0); PG8_MMA(0, 1, At, B1); PG8_BAR; PG8_SCHED;
            PG8_LDA(At, 1, 1); PG8_STAGE(PG8_SB(1, 0), b3, voffB); PG8_STAGE(PG8_SB(1, 1), b3 + hstep, voffB); PG8_STAGE(PG8_SA(1, 0), a3, voffA);
            PG8_WAIT_V(8); PG8_WAIT_L(0); PG8_BAR; PG8_MMA(1, 0, At, B0); PG8_MMA(1, 1, At, B1); PG8_BAR; PG8_SCHED;
            } else {
            PG8_LDB(B0, 0, 0); PG8_SCHED; PG8_LDA(At, 0, 0); PG8_STAGE(PG8_SA(1, 1), a1 + hstep, voffA);
            PG8_WAIT_L(8); PG8_BAR; PG8_WAIT_L(0); PG8_MMA(0, 0, At, B0); PG8_BAR; PG8_SCHED;
            PG8_LDB(B1, 0, 1); PG8_STAGE(PG8_SB(0, 0), b2, voffB);
            PG8_BAR; PG8_WAIT_L(0); PG8_MMA(0, 1, At, B1); PG8_BAR;
            PG8_LDA(At, 0, 1); PG8_STAGE(PG8_SA(0, 0), a2, voffA);
            PG8_BAR; PG8_WAIT_L(0); PG8_MMA(1, 0, At, B0); PG8_BAR; PG8_SCHED;
            PG8_STAGE(PG8_SB(0, 1), b2 + hstep, voffB);
            PG8_WAIT_V(6); PG8_BAR; PG8_MMA(1, 1, At, B1); PG8_BAR;
            PG8_LDB(B0, 1, 0); PG8_SCHED; PG8_LDA(At, 1, 0); PG8_STAGE(PG8_SA(0, 1), a2 + hstep, voffA);
            PG8_WAIT_L(8); PG8_BAR; PG8_WAIT_L(0); PG8_MMA(0, 0, At, B0); PG8_BAR; PG8_SCHED;
            PG8_LDB(B1, 1, 1); PG8_STAGE(PG8_SB(1, 0), b3, voffB);
            PG8_BAR; PG8_WAIT_L(0); PG8_MMA(0, 1, At, B1); PG8_BAR;
            PG8_LDA(At, 1, 1); PG8_STAGE(PG8_SA(1, 0), a3, voffA);
            PG8_BAR; PG8_WAIT_L(0); PG8_MMA(1, 0, At, B0); PG8_BAR; PG8_SCHED;
            PG8_STAGE(PG8_SB(1, 1), b3 + hstep, voffB);
            PG8_WAIT_V(6); PG8_BAR; PG8_MMA(1, 1, At, B1); PG8_BAR;
            }
        }
        if constexpr (ALIGN_EPI) { if (wr == 0) PG8_BAR; }
        if constexpr (!Epi::AFTER_DRAIN) { E(acc, cur, wr, wc, fr, fq, ui & 1, lds); S.done(cur); }
        if (!has_next) break;
#pragma unroll
        for (int a = 0; a < 2; ++a)
#pragma unroll
            for (int b = 0; b < 2; ++b)
#pragma unroll
                for (int m = 0; m < 4; ++m)
#pragma unroll
                    for (int n = 0; n < 2; ++n) acc[a][b][m][n] = (f32x4){0.f, 0.f, 0.f, 0.f};
        cur = nxt; cA = nA; cB = nB; ++ui;
        if constexpr (ALIGN_EPI) { if (wr == 1) PG8_BAR; }
    }
    PG8_WAIT_V(0);
    if constexpr (!ALIGN_EPI) { if (wr == 0) PG8_BAR; }
    PG8_BAR;
    if constexpr (Epi::AFTER_DRAIN) { E.fused(acc, cur, wr, wc, fr, fq, lds, wid, lane); S.done(cur); }
#undef PG8_SA
#undef PG8_SB
#undef PG8_STAGE
#undef PG8_LDA
#undef PG8_LDB
#undef PG8_MMA
#undef PG8_WAIT_V
#undef PG8_WAIT_L
#undef PG8_BAR
#undef PG8_SCHED
}
}
namespace pg8 {
constexpr int RS_LDS_OFF = 145152;
struct RsOrder : StaticOrder {
    const float* rs;
    __device__ __forceinline__ void a_ready(const Unit& u, int slot, PG8_LAS unsigned char* lds) const {
        const int t = threadIdx.x, w = __builtin_amdgcn_readfirstlane(t >> 6);
        const float* base = rs + (u.pm * BM + w * 64);
        if (w < 4) __builtin_amdgcn_global_load_lds((const unsigned*)base + (t & 63), (PG8_LAS unsigned*)(lds + RS_LDS_OFF + slot * 1024 + w * 256), 4, 0, 0);
    }
};
struct EpiProj {
    static constexpr bool PERM = true, AFTER_DRAIN = false;
    bf16_t* O; const float* rot; const float* bf; float* logf;
    __device__ __forceinline__ void operator()(const f32x4 (&acc)[2][2][4][2], const Unit& u, int wr, int wc, int fr, int fq, int slot, PG8_LAS unsigned char* lds) const {
        const int row0 = u.pm * BM + wr * 64 + fr, col0 = u.pn * BM + wc * 32 + 8 * fq;
        const PG8_LAS float* rsl = (const PG8_LAS float*)(lds + RS_LDS_OFF + slot * 1024) + wr * 64 + fr;
        const bool rotary = (u.pn == 12) || (u.pn == 13); const float ksc = (u.pn == 13) ? 0.125f : 1.0f;
        if (u.pn == 18) {
            if (wc == 0 && fq == 0) { const f32x4 bv = *(const f32x4*)bf;
#pragma unroll
                for (int ai = 0; ai < 2; ++ai)
#pragma unroll
                    for (int m = 0; m < 4; ++m) { const int row = row0 + ai * HALF + m * 16; const f32x4 x = acc[ai][0][m][0] * rsl[ai * HALF + m * 16] + bv; f32x4 o;
#pragma unroll
                        for (int j = 0; j < 4; ++j) o[j] = fminf(x[j], 0.f) - log1pf(expf(-fabsf(x[j])));
                        *(f32x4*)(logf + (size_t)row * 4) = o; } }
            return; }
#pragma unroll
        for (int ai = 0; ai < 2; ++ai)
#pragma unroll
            for (int m = 0; m < 4; ++m) { const int row = row0 + ai * HALF + m * 16; bf16_t* rowp = O + (size_t)row * 4608 + col0; const float rsv = rsl[ai * HALF + m * 16];
#pragma unroll
                for (int bj = 0; bj < 2; ++bj) { f32x4 v0 = acc[ai][bj][m][0] * rsv, v1 = acc[ai][bj][m][1] * rsv;
                    if (rotary) { const int pos = row & 2047, i0 = ((bj * HALF + wc * 32 + 8 * fq) & 63) >> 1;
                        const f32x4 r0 = *(const f32x4*)(rot + (size_t)(pos * 32 + i0) * 2), r1 = *(const f32x4*)(rot + (size_t)(pos * 32 + i0) * 2 + 4);
                        f32x4 a, b;
                        a[0] = (v0[0] * r0[0] - v0[1] * r0[1]) * ksc; a[1] = (v0[0] * r0[1] + v0[1] * r0[0]) * ksc;
                        a[2] = (v0[2] * r0[2] - v0[3] * r0[3]) * ksc; a[3] = (v0[2] * r0[3] + v0[3] * r0[2]) * ksc;
                        b[0] = (v1[0] * r1[0] - v1[1] * r1[1]) * ksc; b[1] = (v1[0] * r1[1] + v1[1] * r1[0]) * ksc;
                        b[2] = (v1[2] * r1[2] - v1[3] * r1[3]) * ksc; b[3] = (v1[2] * r1[3] + v1[3] * r1[2]) * ksc;
                        v0 = a; v1 = b; }
                    u32x4 w; w.x = cvt_pk_bf16(v0[0], v0[1]); w.y = cvt_pk_bf16(v0[2], v0[3]); w.z = cvt_pk_bf16(v1[0], v1[1]); w.w = cvt_pk_bf16(v1[2], v1[3]);
                    *(u32x4*)(rowp + bj * HALF) = w; } }
    }
};
struct EpiRelu2 {
    static constexpr bool PERM = true, AFTER_DRAIN = false;
    bf16_t* O; int ldc;
    __device__ __forceinline__ void operator()(const f32x4 (&acc)[2][2][4][2], const Unit& u, int wr, int wc, int fr, int fq, int slot, PG8_LAS unsigned char* lds) const {
        const int row0 = u.pm * BM + wr * 64 + fr, col0 = u.pn * BM + wc * 32 + 8 * fq;
#pragma unroll
        for (int ai = 0; ai < 2; ++ai)
#pragma unroll
            for (int m = 0; m < 4; ++m) { bf16_t* rowp = O + (size_t)(row0 + ai * HALF + m * 16) * ldc + col0; const float rsv = ((const PG8_LAS float*)(lds + RS_LDS_OFF + slot * 1024))[wr * 64 + fr + ai * HALF + m * 16];
#pragma unroll
                for (int bj = 0; bj < 2; ++bj) { f32x4 v0 = acc[ai][bj][m][0] * rsv, v1 = acc[ai][bj][m][1] * rsv;
#pragma unroll
                    for (int j = 0; j < 4; ++j) { const float a = fmaxf(v0[j], 0.f), b = fmaxf(v1[j], 0.f); v0[j] = a * a; v1[j] = b * b; }
                    u32x4 w; w.x = cvt_pk_bf16(v0[0], v0[1]); w.y = cvt_pk_bf16(v0[2], v0[3]); w.z = cvt_pk_bf16(v1[0], v1[1]); w.w = cvt_pk_bf16(v1[2], v1[3]);
                    *(u32x4*)(rowp + bj * HALF) = w; } }
    }
};
template <bool COPY> struct EpiResid {
    static constexpr bool PERM = true, AFTER_DRAIN = false;
    const float* res; float* out; bf16_t* xn; float* ssp; int ldc;
    __device__ __forceinline__ void operator()(const f32x4 (&acc)[2][2][4][2], const Unit& u, int wr, int wc, int fr, int fq, int slot, PG8_LAS unsigned char* lds) const {
        const int row0 = u.pm * BM + wr * 64 + fr, col0 = u.pn * BM + wc * 32 + 8 * fq;
#pragma unroll
        for (int ai = 0; ai < 2; ++ai)
#pragma unroll
            for (int m = 0; m < 4; ++m) { const int row = row0 + ai * HALF + m * 16; const size_t off = (size_t)row * ldc + col0; float ss = 0.f;
#pragma unroll
                for (int bj = 0; bj < 2; ++bj) {
                    const f32x4 h0 = *(const f32x4*)(res + off + bj * HALF) + acc[ai][bj][m][0], h1 = *(const f32x4*)(res + off + bj * HALF + 4) + acc[ai][bj][m][1];
                    *(f32x4*)(out + off + bj * HALF) = h0; *(f32x4*)(out + off + bj * HALF + 4) = h1;
                    if (COPY) { u32x4 w; w.x = cvt_pk_bf16(h0[0], h0[1]); w.y = cvt_pk_bf16(h0[2], h0[3]); w.z = cvt_pk_bf16(h1[0], h1[1]); w.w = cvt_pk_bf16(h1[2], h1[3]);
                        *(u32x4*)(xn + off + bj * HALF) = w;
                        ss += (h0[0] * h0[0] + h0[1] * h0[1]) + (h0[2] * h0[2] + h0[3] * h0[3]) + (h1[0] * h1[0] + h1[1] * h1[1]) + (h1[2] * h1[2] + h1[3] * h1[3]); } }
                if (COPY) { ss += __shfl_xor(ss, 16); ss += __shfl_xor(ss, 32);
                    if (fq == 0) ssp[(size_t)row * 32 + u.pn * 4 + wc] = ss; }
                if (m & 1) asm volatile("" ::: "memory"); }
    }
};
}
#define DEV __device__ __forceinline__
#ifndef LAS
#define LAS __attribute__((address_space(3)))
#endif
typedef unsigned short bf16_t;
typedef short bf16x8 __attribute__((ext_vector_type(8)));
typedef short s16x4 __attribute__((ext_vector_type(4)));
typedef float f32x4 __attribute__((ext_vector_type(4)));
typedef unsigned u32x4 __attribute__((ext_vector_type(4)));
typedef unsigned u32x2 __attribute__((ext_vector_type(2)));
typedef LAS const char* lds_cptr;
typedef LAS char* lds_ptr;

constexpr int BATCH = 8, SEQ = 2048, DM = 2048, MTOK = BATCH * SEQ, NPROJ = 4608, INC = 5124, FF = 8192, DEPTH = 2;
constexpr size_t MiB = (size_t)1 << 20;
constexpr size_t WS_WIN = 1 * MiB, WS_WOUT = 20 * MiB, WS_WFF1 = 28 * MiB, WS_WFF2 = 60 * MiB, WS_SMALL = 92 * MiB, WS_XN = 98 * MiB,
                 WS_PROJ = 162 * MiB, WS_MIX = 306 * MiB, WS_FFH = 162 * MiB, WS_END = 418 * MiB;
constexpr size_t SM_POOLWT = 0, SM_ROT = 128 * 1024, SM_LOGF = 640 * 1024, SM_RS = 896 * 1024, SM_SSP = 1024 * 1024;
constexpr int NPROJ_G = 4864;
constexpr int LDS_BYTES = 147456;
constexpr int NWAVES = 8, NTHR = 512;
constexpr float LN_EPS = 1e-6f;

typedef float f32x2_t __attribute__((ext_vector_type(2)));
typedef __bf16 bf16x2_t __attribute__((ext_vector_type(2)));
DEV unsigned pk2(float lo, float hi) { const f32x2_t v = {lo, hi}; const bf16x2_t b = __builtin_convertvector(v, bf16x2_t); return __builtin_bit_cast(unsigned, b); }
DEV float bflo(unsigned w) { return __uint_as_float(w << 16); }
DEV float bfhi(unsigned w) { return __uint_as_float(w & 0xffff0000u); }
DEV float ex2(float x) { return __builtin_amdgcn_exp2f(x); }
DEV float gelu_tanh(float x) { const float z2 = 2.3022081986f * (x + 0.044715f * x * x * x); return x * __builtin_amdgcn_rcpf(1.0f + ex2(-z2)); }
DEV float silu(float x) { return x * __builtin_amdgcn_rcpf(1.0f + ex2(-x * 1.4426950408889634f)); }
DEV float wave_sum(float v) {
#pragma unroll
    for (int o = 1; o < 64; o <<= 1) v += __shfl_xor(v, o);
    return v; }
DEV float red16(float v) { v += __shfl_xor(v, 1); v += __shfl_xor(v, 2); v += __shfl_xor(v, 4); v += __shfl_xor(v, 8); return v; }
DEV float redg(float v) { v += __shfl_xor(v, 16); v += __shfl_xor(v, 32); return v; }
DEV bf16x8 ld_row(lds_cptr base, int pitch, int row, int col) { return *(const LAS bf16x8*)(base + row * pitch + col * 2); }
DEV s16x4 ld_tr(lds_cptr p) { return __builtin_bit_cast(s16x4, __builtin_amdgcn_ds_read_tr16_b64_v4i16((LAS s16x4*)p)); }
DEV bf16x8 cat8(s16x4 a, s16x4 b) { return __builtin_shufflevector(a, b, 0, 1, 2, 3, 4, 5, 6, 7); }
DEV bf16x8 pack8(f32x4 a, f32x4 b) { u32x4 w; w.x = pk2(a[0], a[1]); w.y = pk2(a[2], a[3]); w.z = pk2(b[0], b[1]); w.w = pk2(b[2], b[3]); return __builtin_bit_cast(bf16x8, w); }
DEV f32x4 mfma16(bf16x8 a, bf16x8 b, f32x4 c) { return __builtin_amdgcn_mfma_f32_16x16x32_bf16(a, b, c, 0, 0, 0); }
#define FRESH_IDS int tid_l = threadIdx.x; asm volatile("" : "+v"(tid_l)); const int tid = tid_l, lane = tid & 63, wid = __builtin_amdgcn_readfirstlane(tid >> 6); (void)lane; (void)wid
#define LDS_WAIT() asm volatile("s_waitcnt lgkmcnt(0)" ::: "memory")

struct Args {
    const float *x, *norm_mix_g, *w_in, *fox_b_f, *pool_w, *pool_scale, *sgu_norm_g, *sgu_w_s, *sgu_b, *ret_norm_g, *w_out, *norm_mlp_g, *w_ff1, *w_ff2, *norm_final_g;
    float* out; unsigned char* ws;
};

DEV int win_srccol(int n) {
    if (n >= 4608) return (n - 4608 < 4) ? 3072 + (n - 4608) : -1;
    if (n < 3072) return n;
    if (n >= 3584) return n + 4;
    const int r = n - 3072, which = r >> 8, hh = (r >> 6) & 3, j = r & 63, oj = (j & 1) ? (j >> 1) + 32 : (j >> 1);
    return 3076 + which * 256 + hh * 64 + oj;
}
template <int MAP> DEV void transpose_item(const float* W, int ldw, int K, int nblk, bf16_t* WT, LAS float* scr, int item, int lane, const float* gk) {
    const int kb = item / nblk, nb = item - kb * nblk, k0 = 64 * kb, n0 = 32 * nb;
    const int sc = MAP ? win_srccol(n0 + (lane & 31)) : n0 + (lane & 31);
    const float* wp = W + (size_t)(k0 + (lane >> 5)) * ldw + (sc < 0 ? 0 : sc);
    float v[32];
#pragma unroll
    for (int i = 0; i < 32; ++i) v[i] = wp[(size_t)(2 * i) * ldw];
    const int c = lane & 7;
    f32x4 g0 = {1.f, 1.f, 1.f, 1.f}, g1 = {1.f, 1.f, 1.f, 1.f};
    if (gk) { g0 = *(const f32x4*)(gk + k0 + 8 * c); g1 = *(const f32x4*)(gk + k0 + 8 * c + 4); }
#pragma unroll
    for (int i = 0; i < 32; ++i) scr[(2 * i + (lane >> 5)) * 33 + (lane & 31)] = (MAP && sc < 0) ? 0.f : v[i];
    LDS_WAIT();
#pragma unroll
    for (int j = 0; j < 4; ++j) { const int n = (lane >> 3) + 8 * j; const LAS float* s = scr + (8 * c) * 33 + n;
        u32x4 o; o.x = pk2(s[0 * 33] * g0[0], s[1 * 33] * g0[1]); o.y = pk2(s[2 * 33] * g0[2], s[3 * 33] * g0[3]); o.z = pk2(s[4 * 33] * g1[0], s[5 * 33] * g1[1]); o.w = pk2(s[6 * 33] * g1[2], s[7 * 33] * g1[3]);
        *(u32x4*)(WT + (size_t)(n0 + n) * K + k0 + 8 * c) = o; }
    LDS_WAIT();
}
DEV void convert_layer(const Args& a, int layer, lds_ptr lds) {
    FRESH_IDS; const int G = gridDim.x, bid = blockIdx.x, gw = bid * NWAVES + wid, NGW = G * NWAVES, gtid = bid * NTHR + tid, NGT = G * NTHR;
    LAS float* scr = (LAS float*)(lds + wid * 8448);
    bf16_t* WinT = (bf16_t*)(a.ws + WS_WIN); bf16_t* WoutT = (bf16_t*)(a.ws + WS_WOUT); bf16_t* W1T = (bf16_t*)(a.ws + WS_WFF1); bf16_t* W2T = (bf16_t*)(a.ws + WS_WFF2);
    const float* win = a.w_in + (size_t)layer * DM * INC; const float* wout = a.w_out + (size_t)layer * DM * DM;
    const float* w1 = a.w_ff1 + (size_t)layer * DM * FF; const float* w2 = a.w_ff2 + (size_t)layer * FF * DM;
    constexpr int I_IN = (DM / 64) * (NPROJ_G / 32), I_OUT = (DM / 64) * (DM / 32), I_1 = (DM / 64) * (FF / 32), I_2 = (FF / 64) * (DM / 32);
    constexpr int NITEMS = I_IN + I_OUT + I_1 + I_2;
    for (int it = gw; it < NITEMS; it += NGW) {
        int r = it;
        if (r < I_IN) { transpose_item<1>(win, INC, DM, NPROJ_G / 32, WinT, scr, r, lane, a.norm_mix_g + layer * DM); continue; } r -= I_IN;
        if (r < I_OUT) { transpose_item<0>(wout, DM, DM, DM / 32, WoutT, scr, r, lane, nullptr); continue; } r -= I_OUT;
        if (r < I_1) { transpose_item<0>(w1, FF, DM, FF / 32, W1T, scr, r, lane, a.norm_mlp_g + layer * DM); continue; } r -= I_1;
        transpose_item<0>(w2, DM, FF, DM / 32, W2T, scr, r, lane, nullptr);
    }
    bf16_t* pwt = (bf16_t*)(a.ws + WS_SMALL + SM_POOLWT);
    const float* pw = a.pool_w + (size_t)layer * 4 * 128 * 128; const float* ps = a.pool_scale + (size_t)layer * 512;
    for (int e = gtid; e < 4 * 128 * 128; e += NGT) { const int g = e >> 14, d = (e >> 7) & 127, c = e & 127;
        const float v = pw[(g * 128 + c) * 128 + d] * ps[g * 128 + d]; pwt[e] = (bf16_t)(pk2(v, 0.f) & 0xffffu); }
}
DEV void rot_table(const Args& a) {
    FRESH_IDS; const int gtid = blockIdx.x * NTHR + tid, NGT = gridDim.x * NTHR;
    float* rot = (float*)(a.ws + WS_SMALL + SM_ROT);
    for (int e = gtid; e < SEQ * 32; e += NGT) { const int pos = e >> 5, i = e & 31;
        double inv = 1.0; for (int k = 0; k < i; ++k) inv *= 0.74989420933245582730;
        const double ang = (double)pos * inv;
        const double n = rint(ang * 0.63661977236758134308); const double y = ang - n * 1.57079632679489661923; const double y2 = y * y;
        const double sn = y * (1.0 + y2 * (-1.0 / 6 + y2 * (1.0 / 120 + y2 * (-1.0 / 5040 + y2 * (1.0 / 362880 + y2 * (-1.0 / 39916800))))));
        const double cs = 1.0 + y2 * (-0.5 + y2 * (1.0 / 24 + y2 * (-1.0 / 720 + y2 * (1.0 / 40320 + y2 * (-1.0 / 3628800 + y2 * (1.0 / 479001600))))));
        const int qd = ((int)n) & 3; double c, s;
        if (qd == 0) { c = cs; s = sn; } else if (qd == 1) { c = -sn; s = cs; } else if (qd == 2) { c = -cs; s = -sn; } else { c = sn; s = -cs; }
        rot[2 * e] = (float)c; rot[2 * e + 1] = (float)s; }
}

template <int MODE> DEV void norm_phase(const float* src, const float* gvec, bf16_t* xn, float* outf, float* rsout) {
    FRESH_IDS; const int gw = blockIdx.x * NWAVES + wid, NGW = gridDim.x * NWAVES;
    for (int m = gw; m < MTOK; m += NGW) {
        const f32x4* xr = (const f32x4*)(src + (size_t)m * DM) + lane;
        f32x4 v[8]; float s = 0.f;
#pragma unroll
        for (int j = 0; j < 8; ++j) { v[j] = xr[64 * j]; s += (v[j][0] * v[j][0] + v[j][1] * v[j][1]) + (v[j][2] * v[j][2] + v[j][3] * v[j][3]); }
        s = wave_sum(s);
        const float rs = __builtin_amdgcn_rsqf(s * (1.0f / DM) + LN_EPS);
        if (MODE == 2) { f32x4* o = (f32x4*)(outf + (size_t)m * DM) + lane;
#pragma unroll
            for (int j = 0; j < 8; ++j) { const f32x4 g = ((const f32x4*)gvec)[lane + 64 * j]; o[64 * j] = v[j] * rs * g; }
        } else { u32x2* o = (u32x2*)(xn + (size_t)m * DM) + lane;
#pragma unroll
            for (int j = 0; j < 8; ++j) { u32x2 w; w.x = pk2(v[j][0], v[j][1]); w.y = pk2(v[j][2], v[j][3]); o[64 * j] = w; }
            if (lane == 0) rsout[m] = rs; }
    }
}
DEV void rs_phase(const float* ssp, float* rsout) {
    FRESH_IDS; const int gtid = blockIdx.x * NTHR + tid, NGT = gridDim.x * NTHR;
    for (int m = gtid; m < MTOK; m += NGT) { const f32x4* p = (const f32x4*)(ssp + (size_t)m * 32); float s = 0.f;
#pragma unroll
        for (int j = 0; j < 8; ++j) { const f32x4 v = p[j]; s += (v[0] + v[1]) + (v[2] + v[3]); }
        rsout[m] = __builtin_amdgcn_rsqf(s * (1.0f / DM) + LN_EPS); }
}
#define XB_TMO      128
#define XB_XCNT(j)  (256  + 64 * (j))
#define XB_XSUB(j)  (1280 + 64 * (j))
#define XB_XGEN(j)  (2304 + 64 * (j))
#define XB_TOP      3328
#define XB_TOPGEN   3392
#define XCD_BAR_WORDS 3456
#define XB_SPIN_CAP (1u << 18)

__device__ __forceinline__ unsigned xb_ld(unsigned* p)              { return __hip_atomic_load(p, __ATOMIC_RELAXED, __HIP_MEMORY_SCOPE_AGENT); }
__device__ __forceinline__ unsigned xb_add(unsigned* p, unsigned v) { return __hip_atomic_fetch_add(p, v, __ATOMIC_RELAXED, __HIP_MEMORY_SCOPE_AGENT); }
__device__ __forceinline__ unsigned xb_xcc_id() { return (unsigned)__builtin_amdgcn_s_getreg((3 << 11) | 20) & 0xFu; }
#define XB_SPIN(cond, bar) do { unsigned _sp = 0; while (cond) { __builtin_amdgcn_s_sleep(1); \
    if ((++_sp & 255u) == 0u) { if (xb_ld(&(bar)[XB_TMO])) break; if (_sp > XB_SPIN_CAP) { atomicAdd(&(bar)[XB_TMO], 1u); break; } } } } while (0)

struct XcdBarrier {
    unsigned* bar; unsigned x;
    volatile LAS unsigned* st;
};

__device__ __forceinline__ XcdBarrier xcd_barrier_post(unsigned* bar, volatile LAS unsigned* st) {
    XcdBarrier b; b.bar = bar; b.x = xb_xcc_id(); b.st = st;
    if (threadIdx.x == 0) (void)xb_add(&bar[XB_XCNT(b.x)], 1u);
    return b;
}
__device__ __forceinline__ void xcd_barrier_complete(unsigned* bar, unsigned x, unsigned& nloc, unsigned& nx) {
    const unsigned G = gridDim.x * gridDim.y * gridDim.z;
    unsigned sum, cnt, mine, sp = 0u;
    for (;;) {
        sum = 0u; cnt = 0u; mine = 0u;
#pragma unroll
        for (unsigned j = 0; j < 16; ++j) { const unsigned c = xb_ld(&bar[XB_XCNT(j)]); sum += c; cnt += (c > 0u) ? 1u : 0u; mine = (j == x) ? c : mine; }
        if (sum == G) break;
        __builtin_amdgcn_s_sleep(1);
        if ((++sp & 255u) == 0u) { if (xb_ld(&bar[XB_TMO])) break; if (sp > XB_SPIN_CAP) { atomicAdd(&bar[XB_TMO], 1u); break; } }
    }
    nloc = mine > 0u ? mine : 1u; nx = cnt > 0u ? cnt : 1u;
}

__device__ __forceinline__ void xcd_barrier(const XcdBarrier& b) {
    asm volatile("s_waitcnt vmcnt(0)" ::: "memory");
    __syncthreads();
    if (threadIdx.x == 0) {
        unsigned* bar = b.bar;
        __builtin_amdgcn_s_waitcnt(0);
        unsigned nloc = b.st[0], nx = b.st[1];
        if (nloc == 0u) { xcd_barrier_complete(bar, b.x, nloc, nx); b.st[0] = nloc; b.st[1] = nx; }
        const unsigned old = xb_add(&bar[XB_XSUB(b.x)], 1u);
        const unsigned gen = old / nloc;
        if (old + 1u == (gen + 1u) * nloc) {
            __builtin_amdgcn_fence(__ATOMIC_RELEASE, "agent");
            asm volatile("s_waitcnt vmcnt(0)" ::: "memory");
            const unsigned og = xb_add(&bar[XB_TOP], 1u);
            const unsigned tg = og / nx;
            if (og + 1u == (tg + 1u) * nx) xb_add(&bar[XB_TOPGEN], 1u);
            else XB_SPIN(xb_ld(&bar[XB_TOPGEN]) == tg, bar);
            __builtin_amdgcn_fence(__ATOMIC_ACQUIRE, "agent");
            xb_add(&bar[XB_XGEN(b.x)], 1u);
            asm volatile("s_waitcnt vmcnt(0)" ::: "memory");
        } else {
            XB_SPIN(xb_ld(&bar[XB_XGEN(b.x)]) == gen, bar);
            __builtin_amdgcn_fence(__ATOMIC_ACQUIRE, "agent");
            asm volatile("s_waitcnt vmcnt(0)" ::: "memory");
        }
    }
    __syncthreads();
}
#define LDS_BARRIER() do { asm volatile("s_waitcnt lgkmcnt(0)" ::: "memory"); __builtin_amdgcn_s_barrier(); asm volatile("" ::: "memory"); } while (0)
constexpr int P128 = 272, P64 = 144;
constexpr int PV = 288, PK = 160;

DEV void fox_tile(lds_cptr Kp, lds_cptr Vp, LAS const float* cs, int key0, int tq, float cq2, bool diag, const bf16x8 (&qf)[4], f32x4 (&o)[8], float& mrun, float& lsum, int g, int r16, int q4, int p4) {
    f32x4 sa[4];
    bf16x8 kf[16]; f32x4 ckv[4];
#pragma unroll
    for (int st = 0; st < 4; ++st)
#pragma unroll
        for (int ks = 0; ks < 4; ++ks) kf[st * 4 + ks] = ld_row(Kp, P128, 16 * st + r16, 32 * ks + 8 * g);
#pragma unroll
    for (int st = 0; st < 4; ++st) ckv[st] = *(const LAS f32x4*)(cs + key0 + 16 * st + 4 * g);
    __builtin_amdgcn_sched_barrier(0);
#pragma unroll
    for (int st = 0; st < 4; ++st) { sa[st] = cq2 - ckv[st];
#pragma unroll
        for (int ks = 0; ks < 4; ++ks) sa[st] = mfma16(kf[st * 4 + ks], qf[ks], sa[st]); }
    float mx = -INFINITY;
#pragma unroll
    for (int st = 0; st < 4; ++st) {
#pragma unroll
        for (int j = 0; j < 4; ++j) { float l = sa[st][j]; if (diag && (key0 + 16 * st + 4 * g + j > tq)) l = -INFINITY; sa[st][j] = l; mx = fmaxf(mx, l); } }
    mx = fmaxf(mx, __shfl_xor(mx, 16)); mx = fmaxf(mx, __shfl_xor(mx, 32));
    if (__builtin_amdgcn_ballot_w64(mx > mrun) != 0ull) {
        const float mnew = fmaxf(mrun, mx); const float alpha = ex2(mrun - mnew); mrun = mnew;
        lsum = lsum * alpha;
#pragma unroll
        for (int dt = 0; dt < 8; ++dt) o[dt] = o[dt] * alpha;
    } else if (__builtin_amdgcn_ballot_w64(mx - mrun > -140.0f) == 0ull) return;
    float rsum = 0.f;
#pragma unroll
    for (int st = 0; st < 4; ++st)
#pragma unroll
        for (int j = 0; j < 4; ++j) { const float p = ex2(sa[st][j] - mrun); sa[st][j] = p; rsum += p; }
    lsum += rsum;
    bf16x8 pf[2]; pf[0] = pack8(sa[0], sa[1]); pf[1] = pack8(sa[2], sa[3]);
#pragma unroll
    for (int h = 0; h < 2; ++h) { s16x4 vf[4][2][2];
#pragma unroll
        for (int d4 = 0; d4 < 4; ++d4)
#pragma unroll
            for (int i = 0; i < 2; ++i) { lds_cptr vp = Vp + (32 * i + 4 * g + q4) * PV + (16 * (4 * h + d4) + 4 * p4) * 2; vf[d4][i][0] = ld_tr(vp); vf[d4][i][1] = ld_tr(vp + 16 * PV); }
        __builtin_amdgcn_sched_barrier(0);
#pragma unroll
        for (int d4 = 0; d4 < 4; ++d4)
#pragma unroll
            for (int i = 0; i < 2; ++i) o[4 * h + d4] = mfma16(cat8(vf[d4][i][0], vf[d4][i][1]), pf[i], o[4 * h + d4]); }
}
DEV void fox_item(lds_ptr lds, const bf16_t* PROJ, const float* LOGF, bf16_t* MIX, int b, int hd, int qb) {
    FRESH_IDS;
    const int g = lane >> 4, r16 = lane & 15, q4 = r16 >> 2, p4 = r16 & 3;
    const int t0 = qb * 128, nkeys = t0 + 128, ntiles = nkeys >> 6;
    LAS float* cs = (LAS float*)(lds + 71680); LAS float* wtot = (LAS float*)(lds + 79872);
    const int tq = t0 + 16 * wid + r16;
    bf16x8 qf[4];
    { const bf16_t* qp = PROJ + (size_t)(b * SEQ + tq) * NPROJ + 1536 + hd * 128 + 8 * g;
#pragma unroll
      for (int ks = 0; ks < 4; ++ks) { const u32x4 w = *(const u32x4*)(qp + 32 * ks); const float S2 = 0.08838834764831845f * 1.4426950408889634f;
          u32x4 r; r.x = pk2(bflo(w.x) * S2, bfhi(w.x) * S2); r.y = pk2(bflo(w.y) * S2, bfhi(w.y) * S2); r.z = pk2(bflo(w.z) * S2, bfhi(w.z) * S2); r.w = pk2(bflo(w.w) * S2, bfhi(w.w) * S2);
          qf[ks] = __builtin_bit_cast(bf16x8, r); } }
    {
        const int s0 = tid * 4; float x[4];
#pragma unroll
        for (int e = 0; e < 4; ++e) x[e] = (s0 + e < nkeys) ? LOGF[(size_t)(b * SEQ + s0 + e) * 4 + hd] : 0.f;
        x[1] += x[0]; x[2] += x[1]; x[3] += x[2];
        const float tot = x[3]; float inc = tot;
#pragma unroll
        for (int o = 1; o < 64; o <<= 1) { const float y = __shfl_up(inc, o); if (lane >= o) inc += y; }
        if (lane == 63) wtot[wid] = inc;
        __syncthreads();
        float base = inc - tot; for (int w2 = 0; w2 < wid; ++w2) base += wtot[w2];
        const float L2E = 1.4426950408889634f;
        *(LAS f32x4*)(cs + s0) = (f32x4){(x[0] + base) * L2E, (x[1] + base) * L2E, (x[2] + base) * L2E, (x[3] + base) * L2E};
        __syncthreads();
    }
    const float cq2 = cs[tq];
    u32x4 kr0[2], vr0[2], kr1[2], vr1[2];
#define FOX_GLOAD(KR, VR, kt) do { _Pragma("unroll") for (int it = 0; it < 2; ++it) { const int i = tid + NTHR * it, row = i >> 4, ch = i & 15; \
        const bf16_t* rp = PROJ + (size_t)(b * SEQ + (kt) * 64 + row) * NPROJ + hd * 128 + ch * 8; KR[it] = *(const u32x4*)(rp + 2048); VR[it] = *(const u32x4*)(rp + 2560); } } while (0)
#define FOX_LWRITE(KR, VR, buf) do { _Pragma("unroll") for (int it = 0; it < 2; ++it) { const int i = tid + NTHR * it, row = i >> 4, ch = i & 15; \
        *(LAS u32x4*)(lds + (buf) * 17408 + row * P128 + ch * 16) = KR[it]; *(LAS u32x4*)(lds + 34816 + (buf) * 18432 + row * PV + ch * 16) = VR[it]; } } while (0)
    f32x4 o[8];
#pragma unroll
    for (int dt = 0; dt < 8; ++dt) o[dt] = (f32x4){0.f, 0.f, 0.f, 0.f};
    float mrun = -INFINITY, lsum = 0.f;
    FOX_GLOAD(kr0, vr0, ntiles - 1); FOX_GLOAD(kr1, vr1, ntiles - 2); FOX_LWRITE(kr0, vr0, 0); if (2 < ntiles) FOX_GLOAD(kr0, vr0, ntiles - 3);
#define FOX_STEP(s, KRW, VRW) do { \
        LDS_BARRIER(); \
        { const int kt_ = ntiles - 1 - (s); \
          if (kt_ * 64 <= t0 + 16 * wid + 15) fox_tile(lds + ((s) & 1) * 17408, lds + 34816 + ((s) & 1) * 18432, cs, kt_ * 64, tq, cq2, kt_ * 64 + 63 > t0 + 16 * wid, qf, o, mrun, lsum, g, r16, q4, p4); } \
        if ((s) + 1 < ntiles) FOX_LWRITE(KRW, VRW, ((s) + 1) & 1); \
        if ((s) + 3 < ntiles) FOX_GLOAD(KRW, VRW, ntiles - 1 - ((s) + 3)); } while (0)
    for (int kt = 0; kt < ntiles; kt += 2) { FOX_STEP(kt, kr1, vr1); FOX_STEP(kt + 1, kr0, vr0); }
#undef FOX_STEP
#undef FOX_GLOAD
#undef FOX_LWRITE
    lsum = redg(lsum); const float inv = __builtin_amdgcn_rcpf(lsum);
    bf16_t* op = MIX + (size_t)(b * SEQ + tq) * DM + 1024 + hd * 128 + 4 * g;
#pragma unroll
    for (int dt = 0; dt < 8; ++dt) { u32x2 w; w.x = pk2(o[dt][0] * inv, o[dt][1] * inv); w.y = pk2(o[dt][2] * inv, o[dt][3] * inv); *(u32x2*)(op + 16 * dt) = w; }
    __syncthreads();
}

DEV void sgu_item(lds_ptr lds, const bf16_t* PROJ, bf16_t* MIX, const float* ng, const float* w_s, const float* b_s, int b, int c, int hd) {
    FRESH_IDS;
    const int g = lane >> 4, r16 = lane & 15, q4 = r16 >> 2, p4 = r16 & 3;
    const size_t R0 = (size_t)b * SEQ + c * 128;
    lds_ptr Vimg = lds, Wimg = lds + 36864;
#pragma unroll
    for (int it = 0; it < 4; ++it) { const int i = tid + NTHR * it, row = i >> 4, ch = i & 15;
        const u32x4 raw = *(const u32x4*)(PROJ + (R0 + row) * NPROJ + 1024 + hd * 128 + ch * 8);
        float x[8]; x[0] = bflo(raw.x); x[1] = bfhi(raw.x); x[2] = bflo(raw.y); x[3] = bfhi(raw.y); x[4] = bflo(raw.z); x[5] = bfhi(raw.z); x[6] = bflo(raw.w); x[7] = bfhi(raw.w);
        float s = 0.f;
#pragma unroll
        for (int e = 0; e < 8; ++e) { x[e] = gelu_tanh(x[e]); s += x[e]; }
        const float mean = red16(s) * (1.0f / 128.0f); float v = 0.f;
#pragma unroll
        for (int e = 0; e < 8; ++e) { x[e] -= mean; v += x[e] * x[e]; }
        const float rstd = __builtin_amdgcn_rsqf(red16(v) * (1.0f / 128.0f) + LN_EPS);
        const f32x4 g0 = *(const f32x4*)(ng + hd * 128 + ch * 8), g1 = *(const f32x4*)(ng + hd * 128 + ch * 8 + 4);
        u32x4 w; w.x = pk2(x[0] * rstd * g0[0], x[1] * rstd * g0[1]); w.y = pk2(x[2] * rstd * g0[2], x[3] * rstd * g0[3]);
        w.z = pk2(x[4] * rstd * g1[0], x[5] * rstd * g1[1]); w.w = pk2(x[6] * rstd * g1[2], x[7] * rstd * g1[3]);
        *(LAS u32x4*)(Vimg + row * PV + ch * 16) = w; }
#pragma unroll
    for (int it = 0; it < 4; ++it) { const int i = tid + NTHR * it, t = i >> 4, ch = i & 15;
        const float* wp = w_s + (size_t)(hd * 128 + t) * 128 + ch * 8; const f32x4 a0 = *(const f32x4*)wp, a1 = *(const f32x4*)(wp + 4);
        float x[8] = {a0[0], a0[1], a0[2], a0[3], a1[0], a1[1], a1[2], a1[3]};
#pragma unroll
        for (int e = 0; e < 8; ++e) if (ch * 8 + e > t) x[e] = 0.f;
        u32x4 w; w.x = pk2(x[0], x[1]); w.y = pk2(x[2], x[3]); w.z = pk2(x[4], x[5]); w.w = pk2(x[6], x[7]);
        *(LAS u32x4*)(Wimg + t * P128 + ch * 16) = w; }
    __syncthreads();
    f32x4 acc[8];
#pragma unroll
    for (int dt = 0; dt < 8; ++dt) acc[dt] = (f32x4){0.f, 0.f, 0.f, 0.f};
    const int tl = 16 * wid + r16;
    u32x2 urv[8];
    { const bf16_t* upl = PROJ + (R0 + tl) * NPROJ + 512 + hd * 128 + 4 * g;
#pragma unroll
      for (int dt = 0; dt < 8; ++dt) urv[dt] = *(const u32x2*)(upl + 16 * dt); }
    const float bias = b_s[hd * 128 + tl];
#pragma unroll
    for (int ks = 0; ks < 4; ++ks) if (32 * ks <= 16 * wid + 15) {
        lds_cptr wp = Wimg + tl * P128 + (32 * ks + 4 * g) * 2;
        const bf16x8 bfr = cat8(*(const LAS s16x4*)wp, *(const LAS s16x4*)(wp + 32));
        s16x4 vf[8][2];
#pragma unroll
        for (int dt = 0; dt < 8; ++dt) { lds_cptr vp = Vimg + (32 * ks + 4 * g + q4) * PV + (16 * dt + 4 * p4) * 2; vf[dt][0] = ld_tr(vp); vf[dt][1] = ld_tr(vp + 16 * PV); }
        __builtin_amdgcn_sched_barrier(0);
#pragma unroll
        for (int dt = 0; dt < 8; ++dt) acc[dt] = mfma16(cat8(vf[dt][0], vf[dt][1]), bfr, acc[dt]); }
    bf16_t* op = MIX + (R0 + tl) * DM + 512 + hd * 128 + 4 * g;
#pragma unroll
    for (int dt = 0; dt < 8; ++dt) { const u32x2 ur = urv[dt];
        const float u0 = gelu_tanh(bflo(ur.x)), u1 = gelu_tanh(bfhi(ur.x)), u2 = gelu_tanh(bflo(ur.y)), u3 = gelu_tanh(bfhi(ur.y));
        u32x2 w; w.x = pk2(u0 * (acc[dt][0] + bias), u1 * (acc[dt][1] + bias)); w.y = pk2(u2 * (acc[dt][2] + bias), u3 * (acc[dt][3] + bias)); *(u32x2*)(op + 16 * dt) = w; }
    __syncthreads();
}

template <int WIN> DEV void pool_stage(lds_ptr Pimg, const bf16_t* PROJ, size_t R0, int c, int gi, int tid) {
#pragma unroll 1
    for (int it = 0; it < 4; ++it) { const int i = tid + NTHR * it, row = i >> 4, ch = i & 15, t = c * 128 + row;
        const bf16_t* rp = PROJ + (R0 + row) * NPROJ + gi * 128 + ch * 8;
        u32x4 raw[WIN];
#pragma unroll
        for (int j = 0; j < WIN; ++j) { raw[j] = (u32x4){0u, 0u, 0u, 0u}; if (t - j >= 0) raw[j] = *(const u32x4*)(rp - (size_t)j * NPROJ); }
        float s[8];
#pragma unroll
        for (int e = 0; e < 8; ++e) s[e] = 0.f;
#pragma unroll
        for (int j = 0; j < WIN; ++j) { s[0] += bflo(raw[j].x); s[1] += bfhi(raw[j].x); s[2] += bflo(raw[j].y); s[3] += bfhi(raw[j].y); s[4] += bflo(raw[j].z); s[5] += bfhi(raw[j].z); s[6] += bflo(raw[j].w); s[7] += bfhi(raw[j].w); }
        const float rc = __builtin_amdgcn_rcpf((float)min(t + 1, WIN));
        u32x4 w; w.x = pk2(s[0] * rc - bflo(raw[0].x), s[1] * rc - bfhi(raw[0].x)); w.y = pk2(s[2] * rc - bflo(raw[0].y), s[3] * rc - bfhi(raw[0].y));
        w.z = pk2(s[4] * rc - bflo(raw[0].z), s[5] * rc - bfhi(raw[0].z)); w.w = pk2(s[6] * rc - bflo(raw[0].w), s[7] * rc - bfhi(raw[0].w));
        *(LAS u32x4*)(Pimg + row * P128 + ch * 16) = w; }
}
DEV void pool_item(lds_ptr lds, const bf16_t* PROJ, bf16_t* MIX, const bf16_t* pwt, int b, int c, int gi) {
    FRESH_IDS;
    const int g = lane >> 4, r16 = lane & 15;
    const size_t R0 = (size_t)b * SEQ + c * 128;
    lds_ptr Pimg = lds, Wimg = lds + 34816;
    switch (gi) { case 0: pool_stage<2>(Pimg, PROJ, R0, c, gi, tid); break; case 1: pool_stage<4>(Pimg, PROJ, R0, c, gi, tid); break;
                  case 2: pool_stage<8>(Pimg, PROJ, R0, c, gi, tid); break; default: pool_stage<16>(Pimg, PROJ, R0, c, gi, tid); break; }
#pragma unroll
    for (int it = 0; it < 4; ++it) { const int i = tid + NTHR * it, row = i >> 4, ch = i & 15;
        *(LAS u32x4*)(Wimg + row * P128 + ch * 16) = *(const u32x4*)(pwt + (size_t)gi * 16384 + row * 128 + ch * 8); }
    __syncthreads();
    f32x4 acc[8];
#pragma unroll
    for (int dt = 0; dt < 8; ++dt) acc[dt] = (f32x4){0.f, 0.f, 0.f, 0.f};
    const int tl = 16 * wid + r16;
#pragma unroll
    for (int ks = 0; ks < 4; ++ks) { const bf16x8 bfr = ld_row(Pimg, P128, tl, 32 * ks + 8 * g); bf16x8 wf[8];
#pragma unroll
        for (int dt = 0; dt < 8; ++dt) wf[dt] = ld_row(Wimg, P128, 16 * dt + r16, 32 * ks + 8 * g);
        __builtin_amdgcn_sched_barrier(0);
#pragma unroll
        for (int dt = 0; dt < 8; ++dt) acc[dt] = mfma16(wf[dt], bfr, acc[dt]); }
    bf16_t* op = MIX + (R0 + tl) * DM + gi * 128 + 4 * g;
#pragma unroll
    for (int dt = 0; dt < 8; ++dt) { u32x2 w; w.x = pk2(acc[dt][0], acc[dt][1]); w.y = pk2(acc[dt][2], acc[dt][3]); *(u32x2*)(op + 16 * dt) = w; }
    __syncthreads();
}

DEV void ret_item(lds_ptr lds, const bf16_t* PROJ, bf16_t* MIX, const float* ng, int b, int hd, int c) {
    FRESH_IDS;
    const int g = lane >> 4, r16 = lane & 15, q4 = r16 >> 2, p4 = r16 & 3;
    const float lg2 = __log2f(1.0f - ex2(-5.0f - (float)hd));
    const size_t R0 = (size_t)b * SEQ + c * 128;
    const int l = 16 * wid + r16;
    bf16x8 qf[2];
    { const bf16_t* qp = PROJ + (R0 + l) * NPROJ + 3072 + hd * 64 + 8 * g; qf[0] = *(const bf16x8*)qp; qf[1] = *(const bf16x8*)(qp + 32); }
    lds_ptr Rt = lds + 114688;
    u32x4 kr0[2], vr0[4], kr1[2], vr1[4];
#define RET_GLOAD(KR, VR, j) do { const size_t rb = (size_t)b * SEQ + (j) * 128; \
        _Pragma("unroll") for (int it = 0; it < 2; ++it) { const int i = tid + NTHR * it, row = i >> 3, ch = i & 7; KR[it] = *(const u32x4*)(PROJ + (rb + row) * NPROJ + 3328 + hd * 64 + ch * 8); } \
        _Pragma("unroll") for (int it = 0; it < 4; ++it) { const int i = tid + NTHR * it, row = i >> 4, ch = i & 15; VR[it] = *(const u32x4*)(PROJ + (rb + row) * NPROJ + 3584 + hd * 128 + ch * 8); } } while (0)
#define RET_LWRITE(KR, VR, j, buf) do { \
        _Pragma("unroll") for (int it = 0; it < 2; ++it) { const int i = tid + NTHR * it, row = i >> 3, ch = i & 7; u32x4 w = KR[it]; \
            if ((j) < c) { const float f = ex2(lg2 * (float)((c - (j)) * 128 - 1 - row)); \
                w.x = pk2(bflo(w.x) * f, bfhi(w.x) * f); w.y = pk2(bflo(w.y) * f, bfhi(w.y) * f); w.z = pk2(bflo(w.z) * f, bfhi(w.z) * f); w.w = pk2(bflo(w.w) * f, bfhi(w.w) * f); } \
            *(LAS u32x4*)(lds + (buf) * 20480 + row * PK + ch * 16) = w; } \
        _Pragma("unroll") for (int it = 0; it < 4; ++it) { const int i = tid + NTHR * it, row = i >> 4, ch = i & 15; *(LAS u32x4*)(lds + 40960 + (buf) * 36864 + row * PV + ch * 16) = VR[it]; } } while (0)
    const int dtl = wid & 3, eb = (wid >> 2) * 4;
    f32x4 sacc[4];
#pragma unroll
    for (int et = 0; et < 4; ++et) sacc[et] = (f32x4){0.f, 0.f, 0.f, 0.f};
    RET_GLOAD(kr0, vr0, 0); if (c >= 1) RET_GLOAD(kr1, vr1, 1); RET_LWRITE(kr0, vr0, 0, 0); if (c >= 2) RET_GLOAD(kr0, vr0, 2);
#define RET_STEP(j, KRW, VRW) do { \
        LDS_BARRIER(); \
        { lds_cptr Kp = lds + ((j) & 1) * 20480; lds_cptr Vp = lds + 40960 + ((j) & 1) * 36864; \
          _Pragma("unroll") for (int k2 = 0; k2 < 2; ++k2) { s16x4 af[2][2], vf[2][4][2]; \
            _Pragma("unroll") for (int kk = 0; kk < 2; ++kk) { const int ks = 2 * k2 + kk; lds_cptr kp = Kp + (32 * ks + 4 * g + q4) * PK + (16 * dtl + 4 * p4) * 2; af[kk][0] = ld_tr(kp); af[kk][1] = ld_tr(kp + 16 * PK); \
                _Pragma("unroll") for (int et = 0; et < 4; ++et) { lds_cptr vp = Vp + (32 * ks + 4 * g + q4) * PV + (16 * (eb + et) + 4 * p4) * 2; vf[kk][et][0] = ld_tr(vp); vf[kk][et][1] = ld_tr(vp + 16 * PV); } } \
            __builtin_amdgcn_sched_barrier(0); \
            _Pragma("unroll") for (int kk = 0; kk < 2; ++kk) _Pragma("unroll") for (int et = 0; et < 4; ++et) sacc[et] = mfma16(cat8(af[kk][0], af[kk][1]), cat8(vf[kk][et][0], vf[kk][et][1]), sacc[et]); } } \
        RET_LWRITE(KRW, VRW, (j) + 1, ((j) + 1) & 1); \
        if ((j) + 3 <= c) RET_GLOAD(KRW, VRW, (j) + 3); } while (0)
    for (int j = 0; j < c; j += 2) { RET_STEP(j, kr1, vr1); if (j + 1 < c) RET_STEP(j + 1, kr0, vr0); }
#undef RET_STEP
#undef RET_GLOAD
#undef RET_LWRITE
#pragma unroll
    for (int et = 0; et < 4; ++et) { u32x2 w; w.x = pk2(sacc[et][0], sacc[et][1]); w.y = pk2(sacc[et][2], sacc[et][3]);
        *(LAS u32x2*)(Rt + (16 * (eb + et) + r16) * P64 + (16 * dtl + 4 * g) * 2) = w; }
    __syncthreads();
    f32x4 y[8];
#pragma unroll
    for (int et = 0; et < 8; ++et) y[et] = (f32x4){0.f, 0.f, 0.f, 0.f};
    if (c > 0) {
        bf16x8 rf[16];
#pragma unroll
        for (int et = 0; et < 8; ++et)
#pragma unroll
            for (int ks = 0; ks < 2; ++ks) rf[et * 2 + ks] = ld_row(Rt, P64, 16 * et + r16, 32 * ks + 8 * g);
        __builtin_amdgcn_sched_barrier(0);
#pragma unroll
        for (int et = 0; et < 8; ++et)
#pragma unroll
            for (int ks = 0; ks < 2; ++ks) y[et] = mfma16(rf[et * 2 + ks], qf[ks], y[et]);
        const float xi = ex2(lg2 * (float)(l + 1));
#pragma unroll
        for (int et = 0; et < 8; ++et) y[et] = y[et] * xi;
    }
    lds_cptr Kp = lds + (c & 1) * 20480; lds_cptr Vp = lds + 40960 + (c & 1) * 36864;
    u32x2 grv[8]; f32x4 gnv[8];
    { const bf16_t* gpl = PROJ + (R0 + l) * NPROJ + 4096 + hd * 128 + 4 * g;
#pragma unroll
      for (int et = 0; et < 8; ++et) { grv[et] = *(const u32x2*)(gpl + 16 * et); gnv[et] = *(const f32x4*)(ng + hd * 128 + 16 * et + 4 * g); } }
    for (int i = 0; i <= (wid >> 1); ++i) {
        f32x4 pa[2];
#pragma unroll
        for (int h2 = 0; h2 < 2; ++h2) { const int mt = 2 * i + h2; pa[h2] = (f32x4){0.f, 0.f, 0.f, 0.f};
            if (mt <= wid) {
#pragma unroll
                for (int ks = 0; ks < 2; ++ks) pa[h2] = mfma16(ld_row(Kp, PK, 16 * mt + r16, 32 * ks + 8 * g), qf[ks], pa[h2]);
#pragma unroll
                for (int r = 0; r < 4; ++r) { const int dl = l - (16 * mt + 4 * g + r); pa[h2][r] = (dl >= 0) ? pa[h2][r] * ex2(lg2 * (float)dl) : 0.f; } } }
        const bf16x8 pf = pack8(pa[0], pa[1]);
        s16x4 vf[8][2];
#pragma unroll
        for (int et = 0; et < 8; ++et) { lds_cptr vp = Vp + (32 * i + 4 * g + q4) * PV + (16 * et + 4 * p4) * 2; vf[et][0] = ld_tr(vp); vf[et][1] = ld_tr(vp + 16 * PV); }
        __builtin_amdgcn_sched_barrier(0);
#pragma unroll
        for (int et = 0; et < 8; ++et) y[et] = mfma16(cat8(vf[et][0], vf[et][1]), pf, y[et]);
    }
    float s = 0.f;
#pragma unroll
    for (int et = 0; et < 8; ++et) s += (y[et][0] + y[et][1]) + (y[et][2] + y[et][3]);
    const float mu = redg(s) * (1.0f / 128.0f); float v = 0.f;
#pragma unroll
    for (int et = 0; et < 8; ++et) { y[et] = y[et] - mu; v += (y[et][0] * y[et][0] + y[et][1] * y[et][1]) + (y[et][2] * y[et][2] + y[et][3] * y[et][3]); }
    const float rstd = __builtin_amdgcn_rsqf(redg(v) * (1.0f / 128.0f) + LN_EPS);
    bf16_t* op = MIX + (R0 + l) * DM + 1536 + hd * 128 + 4 * g;
#pragma unroll
    for (int et = 0; et < 8; ++et) { const u32x2 gr = grv[et]; const f32x4 gn = gnv[et];
        u32x2 w; w.x = pk2(silu(bflo(gr.x)) * (y[et][0] * rstd * gn[0]), silu(bfhi(gr.x)) * (y[et][1] * rstd * gn[1]));
        w.y = pk2(silu(bflo(gr.y)) * (y[et][2] * rstd * gn[2]), silu(bfhi(gr.y)) * (y[et][3] * rstd * gn[3])); *(u32x2*)(op + 16 * et) = w; }
    __syncthreads();
}
#ifndef PH
#define PH 0xFFFF
#endif
__global__ void __launch_bounds__(NTHR, 2) hybrid_fwd(Args a) {
    extern __shared__ __attribute__((aligned(16))) unsigned char lds_raw[];
    cg::grid_group grid = cg::this_grid();
    lds_ptr lds = (lds_ptr)lds_raw;
    const int G = gridDim.x, bid = blockIdx.x;
    bf16_t* WinT = (bf16_t*)(a.ws + WS_WIN); bf16_t* WoutT = (bf16_t*)(a.ws + WS_WOUT); bf16_t* W1T = (bf16_t*)(a.ws + WS_WFF1); bf16_t* W2T = (bf16_t*)(a.ws + WS_WFF2);
    bf16_t* XN = (bf16_t*)(a.ws + WS_XN); bf16_t* PROJ = (bf16_t*)(a.ws + WS_PROJ); bf16_t* MIX = (bf16_t*)(a.ws + WS_MIX); bf16_t* FFH = (bf16_t*)(a.ws + WS_FFH);
    const bf16_t* PWT = (const bf16_t*)(a.ws + WS_SMALL + SM_POOLWT); const float* ROT = (const float*)(a.ws + WS_SMALL + SM_ROT); float* LOGF = (float*)(a.ws + WS_SMALL + SM_LOGF);
    float* RS = (float*)(a.ws + WS_SMALL + SM_RS); float* SSP = (float*)(a.ws + WS_SMALL + SM_SSP);
    volatile LAS unsigned* MISC = (volatile LAS unsigned*)(lds + 147200);
    unsigned* bar = (unsigned*)a.ws;
    { const int t0_ = threadIdx.x; if (t0_ < 16) MISC[t0_] = 0u; __syncthreads(); }
    if (a.ws == nullptr) grid.sync();
    const XcdBarrier xb = xcd_barrier_post(bar, MISC + 8);

#if PH & 1
    convert_layer(a, 0, lds);
    rot_table(a);
    norm_phase<0>(a.x, nullptr, XN, nullptr, RS);
#endif
    xcd_barrier(xb);

#pragma unroll 1
    for (int layer = 0; layer < DEPTH; ++layer) {
#if PH & 2
        { pg8::Gemm gm{XN, WinT, MTOK, NPROJ_G, DM}; pg8::RsOrder S; S.init(MTOK, NPROJ_G, G, bid); S.rs = RS;
          pg8::EpiProj E{PROJ, ROT, a.fox_b_f + layer * 4, LOGF};
          pg8::gemm_phase<pg8::EpiProj, pg8::RsOrder, true, true>((PG8_LAS unsigned char*)lds, gm, S, E); }
#endif
        xcd_barrier(xb);
#if PH & 4
        {
            const float* sg = a.sgu_norm_g + layer * 512; const float* sw = a.sgu_w_s + (size_t)layer * 4 * 128 * 128; const float* sb = a.sgu_b + layer * 512; const float* rg = a.ret_norm_g + layer * 512;
#pragma unroll 1
            for (int it0 = bid; it0 < 256; it0 += G) { const int it = (G == 256) ? (((it0 & 7) << 5) | (it0 >> 3)) : it0;
                const int b = it >> 5, hd = (it >> 3) & 3, x = it & 7;
#pragma unroll 1
                for (int rep = 0; rep < 2; ++rep) fox_item(lds, PROJ, LOGF, MIX, b, hd, rep ? x : 15 - x);
#pragma unroll 1
                for (int rep = 0; rep < 2; ++rep) ret_item(lds, PROJ, MIX, rg, b, hd, rep ? x : 15 - x); }
#pragma unroll 1
            for (int it0 = bid; it0 < 512; it0 += G) { int b, c, hd, half;
                if (G == 256) { const int idx = ((it0 & 255) >> 3) + 32 * (it0 >> 8); b = it0 & 7; c = idx >> 2; hd = idx & 3; half = it0 >> 8; }
                else { b = it0 >> 6; c = (it0 >> 2) & 15; hd = it0 & 3; half = (it0 >> 8) & 1; }
                sgu_item(lds, PROJ, MIX, sg, sw, sb, b, c, hd);
                pool_item(lds, PROJ, MIX, PWT, b, c, half ? 3 - hd : hd); }
        }
#endif
        xcd_barrier(xb);
#if PH & 8
        { pg8::Gemm gm{MIX, WoutT, MTOK, DM, DM}; pg8::StaticOrder S; S.init(MTOK, DM, G, bid);
          pg8::EpiResid<true> E{layer == 0 ? a.x : a.out, a.out, XN, SSP, DM};
          pg8::gemm_phase<pg8::EpiResid<true>, pg8::StaticOrder, true, true>((PG8_LAS unsigned char*)lds, gm, S, E); }
#endif
        xcd_barrier(xb);
        rs_phase(SSP, RS);
        xcd_barrier(xb);
#if PH & 16
        { pg8::Gemm gm{XN, W1T, MTOK, FF, DM}; pg8::RsOrder S; S.init(MTOK, FF, G, bid); S.rs = RS;
          pg8::EpiRelu2 E{FFH, FF};
          pg8::gemm_phase<pg8::EpiRelu2, pg8::RsOrder, true, true>((PG8_LAS unsigned char*)lds, gm, S, E); }
#endif
        xcd_barrier(xb);
#if PH & 32
        { pg8::Gemm gm{FFH, W2T, MTOK, DM, FF}; pg8::StaticOrder S; S.init(MTOK, DM, G, bid);
          if (layer + 1 < DEPTH) { pg8::EpiResid<true> E{a.out, a.out, XN, SSP, DM};
            pg8::gemm_phase<pg8::EpiResid<true>, pg8::StaticOrder, true, true>((PG8_LAS unsigned char*)lds, gm, S, E); }
          else { pg8::EpiResid<false> E{a.out, a.out, XN, SSP, DM};
            pg8::gemm_phase<pg8::EpiResid<false>, pg8::StaticOrder, true, true>((PG8_LAS unsigned char*)lds, gm, S, E); } }
#endif
        xcd_barrier(xb);
        if (layer + 1 < DEPTH) {
            convert_layer(a, layer + 1, lds);
            rs_phase(SSP, RS);
            xcd_barrier(xb);
        } else {
            norm_phase<2>(a.out, a.norm_final_g, nullptr, a.out, nullptr);
        }
    }
}

extern "C" void kernel_launch(void* const* d_in, const int* in_sizes, int n_in, void* d_out, int out_size, void* d_ws, size_t ws_size, hipStream_t stream) {
    static int grid = 0;
    if (grid == 0) {
        if (n_in != 15 || out_size != MTOK * DM || ws_size < WS_END) { fprintf(stderr, "kernel_launch: unexpected problem (n_in %d, out %d, ws %zu)\n", n_in, out_size, ws_size); grid = -1; return; }
        int dev = 0, cus = 0, per_cu = 0;
        (void)hipGetDevice(&dev); (void)hipDeviceGetAttribute(&cus, hipDeviceAttributeMultiprocessorCount, dev);
        if (hipFuncSetAttribute((const void*)hybrid_fwd, hipFuncAttributeMaxDynamicSharedMemorySize, LDS_BYTES) != hipSuccess) { fprintf(stderr, "kernel_launch: hipFuncSetAttribute failed\n"); grid = -1; return; }
        if (hipOccupancyMaxActiveBlocksPerMultiprocessor(&per_cu, (const void*)hybrid_fwd, NTHR, LDS_BYTES) != hipSuccess || per_cu < 1) { fprintf(stderr, "kernel_launch: occupancy query gave %d\n", per_cu); per_cu = 1; }
        (void)hipGetLastError();
        grid = cus > 0 ? cus : 256;
    }
    if (grid < 0) return;
    Args a{};
    a.x = (const float*)d_in[0]; a.norm_mix_g = (const float*)d_in[1]; a.w_in = (const float*)d_in[2]; a.fox_b_f = (const float*)d_in[3]; a.pool_w = (const float*)d_in[4];
    a.pool_scale = (const float*)d_in[5]; a.sgu_norm_g = (const float*)d_in[6]; a.sgu_w_s = (const float*)d_in[7]; a.sgu_b = (const float*)d_in[8]; a.ret_norm_g = (const float*)d_in[9];
    a.w_out = (const float*)d_in[10]; a.norm_mlp_g = (const float*)d_in[11]; a.w_ff1 = (const float*)d_in[12]; a.w_ff2 = (const float*)d_in[13]; a.norm_final_g = (const float*)d_in[14];
    a.out = (float*)d_out; a.ws = (unsigned char*)d_ws;
    if (hipMemsetAsync(d_ws, 0, 16384, stream) != hipSuccess) { fprintf(stderr, "kernel_launch: memset of barrier words failed\n"); return; }
    void* args[] = {&a};
    hipError_t e = hipLaunchCooperativeKernel((const void*)hybrid_fwd, dim3(grid), dim3(NTHR), args, LDS_BYTES, stream);
    if (e != hipSuccess) fprintf(stderr, "kernel_launch: cooperative launch failed: %s (grid %d)\n", hipGetErrorString(e), grid);
}
```
